# Optimizing an MI355X kernel written in HIP

```python
import math
import jax, jax.numpy as jnp
from jax import lax
import numpy as np

D_MODEL = 1024
BATCH = 8
SEQ = 2048
DEPTH = 1

HEAD_DIM = 64
ATTN_GROUPS = ((128, 1), (512, 4), (2048, 16))
HEADS_PER_GROUP = 8
N_HEADS = HEADS_PER_GROUP * len(ATTN_GROUPS)
ATTN_WIDTH = N_HEADS * HEAD_DIM
ATTN_OUT = HEADS_PER_GROUP * HEAD_DIM
POOL_WINDOWS = (2, 4, 8, 16)
POOL_WIDTH = D_MODEL // 2
POOL_GROUP = POOL_WIDTH // len(POOL_WINDOWS)
D_FF = ((8 * D_MODEL // 3 + 255) // 256) * 256
ROPE_THETA = 10000.0
RMS_EPS = 1e-6
Q_BLOCK = 64
NEG_INF = -1e30
IN_SPLITS = (POOL_WIDTH, ATTN_WIDTH, ATTN_WIDTH, ATTN_WIDTH, D_MODEL, D_MODEL)
IN_WIDTH = sum(IN_SPLITS)

kernel_name = "hybrid_pool_dilated_attn_gated_encoder"


def rms_norm(x, g):
    xf = x.astype(jnp.float32)
    y = xf * lax.rsqrt(jnp.mean(xf * xf, axis=-1, keepdims=True) + RMS_EPS)
    return (y * g.astype(jnp.float32)).astype(x.dtype)


def rope_tables(seq):
    pos = jnp.arange(seq, dtype=jnp.float32)
    inv_freq = 1.0 / (ROPE_THETA ** (jnp.arange(0, HEAD_DIM, 2, dtype=jnp.float32) / HEAD_DIM))
    ang = pos[:, None] * inv_freq[None, :]
    ang = jnp.concatenate([ang, ang], axis=-1)
    return jnp.cos(ang), jnp.sin(ang)


def apply_rope(x, cos, sin):
    xf = x.astype(jnp.float32)
    half = HEAD_DIM // 2
    rot = jnp.concatenate([-xf[..., half:], xf[..., :half]], axis=-1)
    out = xf * cos[None, :, None, :] + rot * sin[None, :, None, :]
    return out.astype(x.dtype)


def pool_mixer(u, w_grp, scale):
    B, S, C = u.shape
    uf = u.astype(jnp.float32)
    cs = jnp.concatenate([jnp.zeros((B, 1, C), jnp.float32), jnp.cumsum(uf, axis=1)], axis=1)
    t = jnp.arange(S)
    outs = []
    for gi, w in enumerate(POOL_WINDOWS):
        r = w // 2
        lo = jnp.clip(t - r, 0, S)
        hi = jnp.clip(t + r + 1, 0, S)
        sl = slice(gi * POOL_GROUP, (gi + 1) * POOL_GROUP)
        csg = cs[:, :, sl]
        seg = jnp.take(csg, hi, axis=1) - jnp.take(csg, lo, axis=1)
        cnt = (hi - lo).astype(jnp.float32)
        outs.append(seg / cnt[None, :, None] - uf[:, :, sl])
    grouped = jnp.stack(outs, axis=2)
    mixed = jnp.einsum('bsgc,gcd->bsgd', grouped, w_grp.astype(jnp.float32))
    return (mixed.reshape(B, S, C) * scale.astype(jnp.float32)).astype(u.dtype)


def dilated_window_attention(q, k, v, dilation, radius):
    B, S, H, Dh = q.shape
    L = S // dilation
    blk = math.gcd(L, Q_BLOCK)
    nb = L // blk
    nk = blk + 2 * radius

    def to_classes(a):
        return a.reshape(B, L, dilation, H, Dh).transpose(0, 2, 1, 3, 4)

    qc, kc, vc = to_classes(q), to_classes(k), to_classes(v)
    pad = ((0, 0), (0, 0), (radius, radius), (0, 0), (0, 0))
    kp, vp = jnp.pad(kc, pad), jnp.pad(vc, pad)
    key_idx = jnp.arange(nb)[:, None] * blk + jnp.arange(nk)[None, :]
    kb = jnp.take(kp, key_idx, axis=2)
    vb = jnp.take(vp, key_idx, axis=2)
    qb = qc.reshape(B, dilation, nb, blk, H, Dh)
    s = jnp.einsum('brnqhd,brnkhd->brnhqk', qb, kb).astype(jnp.float32) * (Dh ** -0.5)
    rel = jnp.arange(nk)[None, :] - radius - jnp.arange(blk)[:, None]
    kpos = key_idx - radius
    mask = (jnp.abs(rel) <= radius)[None] & ((kpos >= 0) & (kpos < L))[:, None, :]
    s = jnp.where(mask[None, None, :, None], s, NEG_INF)
    lse = jax.nn.logsumexp(s, axis=-1)
    p = jnp.exp(s - lse[..., None])
    o = jnp.einsum('brnhqk,brnkhd->brnqhd', p.astype(v.dtype), vb)
    o = o.reshape(B, dilation, L, H, Dh).transpose(0, 2, 1, 3, 4).reshape(B, S, H, Dh)
    lse = lse.transpose(0, 1, 2, 4, 3).reshape(B, dilation, L, H).transpose(0, 2, 1, 3).reshape(B, S, H)
    return o, lse


def setup_inputs(seed: int = 0) -> dict:
    key = jax.random.key(seed)
    ks = jax.random.split(key, 16)
    f32 = jnp.float32

    def w(k, shape, fan_in):
        return jax.random.normal(k, shape, f32) * (fan_in ** -0.5)

    def gain(k):
        return 1.0 + 0.05 * jax.random.normal(k, (DEPTH, D_MODEL), f32)

    return {
        "x": jax.random.normal(ks[0], (BATCH, SEQ, D_MODEL), f32),
        "norm_mix_pre": gain(ks[1]),
        "w_in": w(ks[2], (DEPTH, D_MODEL, IN_WIDTH), D_MODEL),
        "w_pool_grp": w(ks[3], (DEPTH, len(POOL_WINDOWS), POOL_GROUP, POOL_GROUP), POOL_GROUP),
        "pool_scale": 1.0 + 0.1 * jax.random.normal(ks[4], (DEPTH, POOL_WIDTH), f32),
        "w_pool_br": w(ks[5], (DEPTH, POOL_WIDTH, D_MODEL), POOL_WIDTH),
        "w_attn_br": w(ks[6], (DEPTH, ATTN_OUT, D_MODEL), ATTN_OUT),
        "w_out": w(ks[7], (DEPTH, D_MODEL, D_MODEL), D_MODEL),
        "norm_mix_post": gain(ks[8]),
        "norm_ffn_pre": gain(ks[9]),
        "w_ffn_gate": w(ks[10], (DEPTH, D_MODEL, D_FF), D_MODEL),
        "w_ffn_up": w(ks[11], (DEPTH, D_MODEL, D_FF), D_MODEL),
        "w_ffn_down": w(ks[12], (DEPTH, D_FF, D_MODEL), D_FF),
        "norm_ffn_post": gain(ks[13]),
    }


def reference(x, norm_mix_pre, w_in, w_pool_grp, pool_scale, w_pool_br, w_attn_br, w_out,
              norm_mix_post, norm_ffn_pre, w_ffn_gate, w_ffn_up, w_ffn_down, norm_ffn_post):
    B, S, _ = x.shape
    cos, sin = rope_tables(S)
    split_pts = list(np.cumsum(IN_SPLITS)[:-1])
    for l in range(DEPTH):
        h = rms_norm(x, norm_mix_pre[l])
        proj = h @ w_in[l]
        u_pool, q, k, v, g_pool, g_attn = jnp.split(proj, split_pts, axis=-1)

        y_pool = pool_mixer(u_pool, w_pool_grp[l], pool_scale[l]) @ w_pool_br[l]

        q = apply_rope(q.reshape(B, S, N_HEADS, HEAD_DIM), cos, sin)
        k = apply_rope(k.reshape(B, S, N_HEADS, HEAD_DIM), cos, sin)
        v = v.reshape(B, S, N_HEADS, HEAD_DIM)
        outs, lses = [], []
        for gi, (window, dil) in enumerate(ATTN_GROUPS):
            hs = slice(gi * HEADS_PER_GROUP, (gi + 1) * HEADS_PER_GROUP)
            radius = (window // 2) // dil
            o, lse = dilated_window_attention(q[:, :, hs], k[:, :, hs], v[:, :, hs], dil, radius)
            outs.append(o)
            lses.append(lse)
        wts = jax.nn.softmax(jnp.stack(lses, axis=0), axis=0)
        o_attn = jnp.sum(wts[..., None].astype(v.dtype) * jnp.stack(outs, axis=0), axis=0)
        y_attn = o_attn.reshape(B, S, ATTN_OUT) @ w_attn_br[l]

        mix = (jax.nn.sigmoid(g_pool) * y_pool + jax.nn.sigmoid(g_attn) * y_attn) @ w_out[l]
        x = x + rms_norm(mix, norm_mix_post[l])

        h2 = rms_norm(x, norm_ffn_pre[l])
        f = (jax.nn.silu(h2 @ w_ffn_gate[l]) * (h2 @ w_ffn_up[l])) @ w_ffn_down[l]
        x = x + rms_norm(f, norm_ffn_post[l])
    return x
```

```cpp
#include <hip/hip_runtime.h>
#include <hip/hip_cooperative_groups.h>
#include <cstdio>
#include <cstdint>
namespace cg = cooperative_groups;

namespace pg8 {
#define PG8_LAS __attribute__((address_space(3)))
typedef unsigned short bf16_t;
typedef short bf16x8 __attribute__((ext_vector_type(8)));
typedef float f32x4 __attribute__((ext_vector_type(4)));
typedef unsigned u32x4 __attribute__((ext_vector_type(4)));
constexpr int BM = 256, BK = 64, HALF = 128, HTB = HALF * BK * 2  , STAGE_BYTES = 8 * HTB, NXCD = 8, WGM = 8;

__host__ __device__ __forceinline__ int lds_byte(int r, int c) { const int st = (r >> 4) * 2 + (c >> 5), rr = r & 15, cc = c & 31, ob = rr * 64 + cc * 2; return st * 1024 + (ob ^ (((ob >> 9) & 1) << 5)); }
__host__ __device__ __forceinline__ void stage_rc(int b, int& R, int& C) { const int st = b / 1024, sb = b % 1024, swz = sb ^ (((sb >> 9) & 1) << 5); R = (st >> 1) * 16 + swz / 64; C = (st & 1) * 32 + (swz % 64) / 2; }
__host__ __device__ __forceinline__ int perm32(int rho) { const int n = rho >> 4, i = rho & 15; return 8 * (i >> 2) + 4 * n + (i & 3); }

struct Unit { int pm, pn, src; };
struct Gemm { const bf16_t* A; const bf16_t* Bt; const bf16_t* A2; const bf16_t* Bt2; int M, N, K; };

struct StaticOrder {
    int nM, nN, nwg, G, c;
    __host__ __device__ void init(int M, int N, int G_, int c_) { nM = M / BM; nN = N / BM; nwg = nM * nN; G = G_; c = c_; }
    __host__ __device__ bool next(int i, Unit& u) const {
        const long L = (long)i * G + c; if (L >= nwg) return false;
        int wgid = (int)L; { const int q = nwg / NXCD, r = nwg % NXCD, xcd = wgid % NXCD, off = wgid / NXCD; wgid = (xcd < r ? xcd * (q + 1) : r * (q + 1) + (xcd - r) * q) + off; }
        const int nig = WGM * nN, gid = wgid / nig, fm = gid * WGM, gsz = (nM - fm) < WGM ? (nM - fm) : WGM;
        u.pm = fm + ((wgid % nig) % gsz); u.pn = (wgid % nig) / gsz; u.src = 0; return true;
    }
    __device__ __forceinline__ void a_ready(const Unit&) const {}
    __device__ __forceinline__ void done(const Unit&) const {}
};


typedef float f32x2v __attribute__((ext_vector_type(2)));
typedef __bf16 bf16x2v __attribute__((ext_vector_type(2)));
__device__ __forceinline__ unsigned cvtpk(float lo, float hi) { f32x2v v = {lo, hi}; bf16x2v b = __builtin_convertvector(v, bf16x2v); return __builtin_bit_cast(unsigned, b); }
__device__ __forceinline__ u32x4 pack8(f32x4 a, f32x4 b) { u32x4 w; w.x = cvtpk(a[0], a[1]); w.y = cvtpk(a[2], a[3]); w.z = cvtpk(b[0], b[1]); w.w = cvtpk(b[2], b[3]); return w; }
__device__ __forceinline__ void unpack8(u32x4 w, f32x4& a, f32x4& b) {
    a[0] = __uint_as_float(w.x << 16); a[1] = __uint_as_float(w.x & 0xffff0000u); a[2] = __uint_as_float(w.y << 16); a[3] = __uint_as_float(w.y & 0xffff0000u);
    b[0] = __uint_as_float(w.z << 16); b[1] = __uint_as_float(w.z & 0xffff0000u); b[2] = __uint_as_float(w.w << 16); b[3] = __uint_as_float(w.w & 0xffff0000u); }
__device__ __forceinline__ float sigmoidf_(float v) { return __builtin_amdgcn_rcpf(1.0f + __expf(-v)); }
__device__ __forceinline__ f32x4 sigmoid4(f32x4 v) { f32x4 o; o[0] = sigmoidf_(v[0]); o[1] = sigmoidf_(v[1]); o[2] = sigmoidf_(v[2]); o[3] = sigmoidf_(v[3]); return o; }

constexpr float ATT_C2 = 0.125f * 1.4426950408889634f;

struct EpiProj {
    static constexpr bool PERM = true, AFTER_DRAIN = false, CHAIN = false;
    bf16_t *Z, *Q, *Kb, *V, *SGP, *SGA; const float* rope;
    __device__ __forceinline__ void operator()(f32x4 (&acc)[2][2][4][2], const Unit& u, int wr, int wc, int fr, int fq) const {
        const int pn = u.pn; const int row0 = u.pm * BM + wr * 64 + fr;
        if (pn >= 2 && pn < 14) {
            bf16_t* base; int tile; float sc;
            if (pn < 8) { base = Q; tile = pn - 2; sc = ATT_C2; } else { base = Kb; tile = pn - 8; sc = 1.0f; }
            const int col0 = tile * 256 + wc * 64 + 8 * fq;
#pragma unroll
            for (int ai = 0; ai < 2; ++ai)
#pragma unroll
                for (int m = 0; m < 4; ++m) {
                    const int row = row0 + ai * HALF + m * 16; const float* cp = rope + (size_t)(row & 2047) * 64 + 8 * fq;
                    const f32x4 c0 = *(const f32x4*)cp, c1 = *(const f32x4*)(cp + 4), s0 = *(const f32x4*)(cp + 32), s1 = *(const f32x4*)(cp + 36);
                    const f32x4 a0 = acc[ai][0][m][0], a1 = acc[ai][0][m][1], b0 = acc[ai][1][m][0], b1 = acc[ai][1][m][1];
                    const f32x4 lo0 = (a0 * c0 - b0 * s0) * sc, lo1 = (a1 * c1 - b1 * s1) * sc, hi0 = (b0 * c0 + a0 * s0) * sc, hi1 = (b1 * c1 + a1 * s1) * sc;
                    bf16_t* rp = base + (size_t)row * 1536 + col0;
                    *(u32x4*)rp = pack8(lo0, lo1); *(u32x4*)(rp + 32) = pack8(hi0, hi1);
                }
        } else {
            bf16_t* base; int ldc, colb; bool sg = false;
            if (pn < 2) { base = Z; ldc = 512; colb = pn * 256; }
            else if (pn < 20) { base = V; ldc = 1536; colb = (pn - 14) * 256; }
            else if (pn < 24) { base = SGP; ldc = 1024; colb = (pn - 20) * 256; sg = true; }
            else { base = SGA; ldc = 1024; colb = (pn - 24) * 256; sg = true; }
            const int col0 = colb + wc * 32 + 8 * fq;
#pragma unroll
            for (int ai = 0; ai < 2; ++ai)
#pragma unroll
                for (int m = 0; m < 4; ++m) { bf16_t* rp = base + (size_t)(row0 + ai * HALF + m * 16) * ldc + col0;
#pragma unroll
                    for (int bj = 0; bj < 2; ++bj) { f32x4 v0 = acc[ai][bj][m][0], v1 = acc[ai][bj][m][1];
                        if (sg) { v0 = sigmoid4(v0); v1 = sigmoid4(v1); }
                        *(u32x4*)(rp + bj * HALF) = pack8(v0, v1); } }
        }
    }
};
struct EpiPlain {
    static constexpr bool PERM = true, AFTER_DRAIN = false, CHAIN = false;
    bf16_t* O; int ldc;
    __device__ __forceinline__ void operator()(f32x4 (&acc)[2][2][4][2], const Unit& u, int wr, int wc, int fr, int fq) const {
        const int row0 = u.pm * BM + wr * 64 + fr, col0 = u.pn * BM + wc * 32 + 8 * fq;
#pragma unroll
        for (int ai = 0; ai < 2; ++ai)
#pragma unroll
            for (int m = 0; m < 4; ++m) { bf16_t* rp = O + (size_t)(row0 + ai * HALF + m * 16) * ldc + col0;
#pragma unroll
                for (int bj = 0; bj < 2; ++bj) *(u32x4*)(rp + bj * HALF) = pack8(acc[ai][bj][m][0], acc[ai][bj][m][1]); }
    }
};
struct EpiGate {
    static constexpr bool PERM = true, AFTER_DRAIN = false, CHAIN = true;
    const bf16_t *SGP, *SGA; bf16_t* O;
    __device__ __forceinline__ void operator()(f32x4 (&acc)[2][2][4][2], const Unit& u, int wr, int wc, int fr, int fq) const {
        const int row0 = u.pm * BM + wr * 64 + fr, col0 = u.pn * BM + wc * 32 + 8 * fq;
#pragma unroll
        for (int ai = 0; ai < 2; ++ai)
#pragma unroll
            for (int m = 0; m < 4; ++m) { const size_t off = (size_t)(row0 + ai * HALF + m * 16) * 1024 + col0;
#pragma unroll
                for (int bj = 0; bj < 2; ++bj) {
                    f32x4 a0, a1; unpack8(*(const u32x4*)(SGA + off + bj * HALF), a0, a1);
                    if (u.src == 0) {
                        f32x4 p0, p1; unpack8(*(const u32x4*)(SGP + off + bj * HALF), p0, p1);
#pragma unroll
                        for (int i = 0; i < 4; ++i) { acc[ai][bj][m][0][i] *= p0[i] * __builtin_amdgcn_rcpf(a0[i]); acc[ai][bj][m][1][i] *= p1[i] * __builtin_amdgcn_rcpf(a1[i]); }
                    } else {
                        *(u32x4*)(O + off + bj * HALF) = pack8(acc[ai][bj][m][0] * a0, acc[ai][bj][m][1] * a1);
                    } } }
    }
};
struct EpiSwiGLU {
    static constexpr bool PERM = true, AFTER_DRAIN = false, CHAIN = false;
    bf16_t* O; int ldc;
    __device__ __forceinline__ void operator()(f32x4 (&acc)[2][2][4][2], const Unit& u, int wr, int wc, int fr, int fq) const {
        const int row0 = u.pm * BM + wr * 64 + fr, col0 = u.pn * HALF + wc * 32 + 8 * fq;
#pragma unroll
        for (int ai = 0; ai < 2; ++ai)
#pragma unroll
            for (int m = 0; m < 4; ++m) {
                const f32x4 g0 = acc[ai][0][m][0], g1 = acc[ai][0][m][1], u0 = acc[ai][1][m][0], u1 = acc[ai][1][m][1];
                const f32x4 r0 = g0 * sigmoid4(g0) * u0, r1 = g1 * sigmoid4(g1) * u1;
                *(u32x4*)(O + (size_t)(row0 + ai * HALF + m * 16) * ldc + col0) = pack8(r0, r1); }
    }
};
struct PairOrder {
    StaticOrder S;
    __device__ bool next(int i, Unit& u) const { if (!S.next(i >> 1, u)) return false; u.src = i & 1; return true; }
    __device__ __forceinline__ void a_ready(const Unit&) const {}
    __device__ __forceinline__ void done(const Unit&) const {}
};

template <class Epi, class Sched, bool ALIGN_EPI = false, bool SP2 = false>
__device__ __forceinline__ void gemm_phase(PG8_LAS unsigned char* lds, const Gemm g, const Sched& S, const Epi& E) {
    const int tid = threadIdx.x, wid = __builtin_amdgcn_readfirstlane(tid >> 6), lane = tid & 63, wr = wid >> 2, wc = wid & 3, fr = lane & 15, fq = lane >> 4;
    const int K = g.K, nt = K / BK;
    unsigned voffA[2], voffB[2];
#pragma unroll
    for (int i = 0; i < 2; ++i) { int R, C; stage_rc(tid * 16 + i * 8192, R, C); const int Rb = Epi::PERM ? ((R & ~31) + perm32(R & 31)) : R;
        voffA[i] = (unsigned)(R * K + C) * 2u; voffB[i] = (unsigned)(Rb * K + C) * 2u; }
    const size_t kstep = (size_t)(BK * 2);
    const size_t hstep = (size_t)HALF * K * 2;
    const size_t tstep = 2 * hstep;
    const unsigned ldsw = (unsigned)wid * 1024u;
    const int aoff = lds_byte(wr * 64 + fr, fq * 8), boff = lds_byte(wc * 32 + fr, fq * 8);
#define PG8_SA(b, h) (((b) * 2 + (h)) * HTB)
#define PG8_SB(b, h) ((4 + (b) * 2 + (h)) * HTB)
#define PG8_STAGE(bufoff, gbase, voff) do { _Pragma("unroll") for (int _i = 0; _i < 2; ++_i) \
        __builtin_amdgcn_global_load_lds((const unsigned*)((const char*)(gbase) + (voff)[_i]), (PG8_LAS unsigned*)(lds + (bufoff) + ldsw + _i * 8192), 16, 0, 0); } while (0)
#define PG8_LDA(dst, b, h) do { _Pragma("unroll") for (int m = 0; m < 4; ++m) _Pragma("unroll") for (int k = 0; k < 2; ++k) dst[m][k] = *(const PG8_LAS bf16x8*)(lds + PG8_SA(b, h) + aoff + m * 2048 + k * 1024); } while (0)
#define PG8_LDB(dst, b, h) do { _Pragma("unroll") for (int n = 0; n < 2; ++n) _Pragma("unroll") for (int k = 0; k < 2; ++k) dst[n][k] = *(const PG8_LAS bf16x8*)(lds + PG8_SB(b, h) + boff + n * 2048 + k * 1024); } while (0)
#define PG8_MMA(ai, bj, At, Bt) do { __builtin_amdgcn_s_setprio(1); _Pragma("unroll") for (int m = 0; m < 4; ++m) _Pragma("unroll") for (int n = 0; n < 2; ++n) _Pragma("unroll") for (int k = 0; k < 2; ++k) \
        acc[ai][bj][m][n] = __builtin_amdgcn_mfma_f32_16x16x32_bf16(Bt[n][k], At[m][k], acc[ai][bj][m][n], 0, 0, 0); __builtin_amdgcn_s_setprio(0); } while (0)
#define PG8_WAIT_V(n) asm volatile("s_waitcnt vmcnt(" #n ")" ::: "memory")
#define PG8_WAIT_L(n) asm volatile("s_waitcnt lgkmcnt(" #n ")" ::: "memory")
#define PG8_BAR __builtin_amdgcn_s_barrier()
#define PG8_SCHED __builtin_amdgcn_sched_barrier(0)
    Unit cur, nxt; int ui = 0;
    if (!S.next(0, cur)) return;
    f32x4 acc[2][2][4][2];
#pragma unroll
    for (int a = 0; a < 2; ++a)
#pragma unroll
        for (int b = 0; b < 2; ++b)
#pragma unroll
            for (int m = 0; m < 4; ++m)
#pragma unroll
                for (int n = 0; n < 2; ++n) acc[a][b][m][n] = (f32x4){0.f, 0.f, 0.f, 0.f};
    bf16x8 At[4][2], B0[2][2], B1[2][2];
    const char* cA = (const char*)(cur.src ? g.A2 : g.A) + (size_t)cur.pm * tstep; const char* cB = (const char*)(cur.src ? g.Bt2 : g.Bt) + (size_t)cur.pn * tstep;
    S.a_ready(cur);
    if constexpr (SP2) {
        PG8_STAGE(PG8_SB(0, 0), cB, voffB); PG8_STAGE(PG8_SB(0, 1), cB + hstep, voffB); PG8_STAGE(PG8_SA(0, 0), cA, voffA); PG8_STAGE(PG8_SA(0, 1), cA + hstep, voffA);
        if (wr == 1) PG8_BAR;
        PG8_WAIT_V(2); PG8_BAR;
        PG8_STAGE(PG8_SB(1, 0), cB + kstep, voffB); PG8_STAGE(PG8_SA(1, 0), cA + kstep, voffA); PG8_STAGE(PG8_SB(1, 1), cB + hstep + kstep, voffB);
        PG8_WAIT_V(6); PG8_BAR;
    } else {
        PG8_STAGE(PG8_SB(0, 0), cB, voffB); PG8_STAGE(PG8_SA(0, 0), cA, voffA); PG8_STAGE(PG8_SB(0, 1), cB + hstep, voffB); PG8_STAGE(PG8_SA(0, 1), cA + hstep, voffA);
        if (wr == 1) PG8_BAR;
        PG8_WAIT_V(4); PG8_BAR;
        PG8_STAGE(PG8_SB(1, 0), cB + kstep, voffB); PG8_STAGE(PG8_SA(1, 0), cA + kstep, voffA); PG8_STAGE(PG8_SB(1, 1), cB + hstep + kstep, voffB);
        PG8_WAIT_V(6); PG8_BAR;
    }
    for (;;) {
        const bool has_next = S.next(ui + 1, nxt);
        const char* nA = has_next ? (const char*)(nxt.src ? g.A2 : g.A) + (size_t)nxt.pm * tstep : cA; const char* nB = has_next ? (const char*)(nxt.src ? g.Bt2 : g.Bt) + (size_t)nxt.pn * tstep : cB;
        for (int t = 0; t < nt; t += 2) {
            const bool last = (t == nt - 2);
            const char* a1 = cA + (size_t)(t + 1) * kstep;
            const char* a2 = last ? nA : cA + (size_t)(t + 2) * kstep; const char* b2 = last ? nB : cB + (size_t)(t + 2) * kstep;
            const char* a3 = a2 + kstep; const char* b3 = b2 + kstep;
            if (last && has_next) S.a_ready(nxt);
            if constexpr (SP2) {
            PG8_LDB(B0, 0, 0); PG8_LDB(B1, 0, 1); PG8_SCHED; PG8_LDA(At, 0, 0); PG8_STAGE(PG8_SA(1, 1), a1 + hstep, voffA);
            PG8_WAIT_V(8); PG8_WAIT_L(0); PG8_BAR; PG8_MMA(0, 0, At, B0); PG8_MMA(0, 1, At, B1); PG8_BAR; PG8_SCHED;
            PG8_LDA(At, 0, 1); PG8_STAGE(PG8_SB(0, 0), b2, voffB); PG8_STAGE(PG8_SB(0, 1), b2 + hstep, voffB); PG8_STAGE(PG8_SA(0, 0), a2, voffA);
            PG8_WAIT_V(8); PG8_WAIT_L(0); PG8_BAR; PG8_MMA(1, 0, At, B0); PG8_MMA(1, 1, At, B1); PG8_BAR; PG8_SCHED;
            PG8_LDB(B0, 1, 0); PG8_LDB(B1, 1, 1); PG8_SCHED; PG8_LDA(At, 1, 0); PG8_STAGE(PG8_SA(0, 1), a2 + hstep, voffA);
            PG8_WAIT_V(8); PG8_WAIT_L(0); PG8_BAR; PG8_MMA(0, 0, At, B0); PG8_MMA(0, 1, At, B1); PG8_BAR; PG8_SCHED;
            PG8_LDA(At, 1, 1); PG8_STAGE(PG8_SB(1, 0), b3, voffB); PG8_STAGE(PG8_SB(1, 1), b3 + hstep, voffB); PG8_STAGE(PG8_SA(1, 0), a3, voffA);
            PG8_WAIT_V(8); PG8_WAIT_L(0); PG8_BAR; PG8_MMA(1, 0, At, B0); PG8_MMA(1, 1, At, B1); PG8_BAR; PG8_SCHED;
            } else {
            PG8_LDB(B0, 0, 0); PG8_SCHED; PG8_LDA(At, 0, 0); PG8_STAGE(PG8_SA(1, 1), a1 + hstep, voffA);
            PG8_WAIT_L(8); PG8_BAR; PG8_WAIT_L(0); PG8_MMA(0, 0, At, B0); PG8_BAR; PG8_SCHED;
            PG8_LDB(B1, 0, 1); PG8_STAGE(PG8_SB(0, 0), b2, voffB);
            PG8_BAR; PG8_WAIT_L(0); PG8_MMA(0, 1, At, B1); PG8_BAR;
            PG8_LDA(At, 0, 1); PG8_STAGE(PG8_SA(0, 0), a2, voffA);
            PG8_BAR; PG8_WAIT_L(0); PG8_MMA(1, 0, At, B0); PG8_BAR; PG8_SCHED;
            PG8_STAGE(PG8_SB(0, 1), b2 + hstep, voffB);
            PG8_WAIT_V(6); PG8_BAR; PG8_MMA(1, 1, At, B1); PG8_BAR;
            PG8_LDB(B0, 1, 0); PG8_SCHED; PG8_LDA(At, 1, 0); PG8_STAGE(PG8_SA(0, 1), a2 + hstep, voffA);
            PG8_WAIT_L(8); PG8_BAR; PG8_WAIT_L(0); PG8_MMA(0, 0, At, B0); PG8_BAR; PG8_SCHED;
            PG8_LDB(B1, 1, 1); PG8_STAGE(PG8_SB(1, 0), b3, voffB);
            PG8_BAR; PG8_WAIT_L(0); PG8_MMA(0, 1, At, B1); PG8_BAR;
            PG8_LDA(At, 1, 1); PG8_STAGE(PG8_SA(1, 0), a3, voffA);
            PG8_BAR; PG8_WAIT_L(0); PG8_MMA(1, 0, At, B0); PG8_BAR; PG8_SCHED;
            PG8_STAGE(PG8_SB(1, 1), b3 + hstep, voffB);
            PG8_WAIT_V(6); PG8_BAR; PG8_MMA(1, 1, At, B1); PG8_BAR;
            }
        }
        if constexpr (ALIGN_EPI) { if (wr == 0) PG8_BAR; }
        if constexpr (!Epi::AFTER_DRAIN) { E(acc, cur, wr, wc, fr, fq); S.done(cur); }
        if (!has_next) break;
        if (!(Epi::CHAIN && cur.src == 0)) {
#pragma unroll
        for (int a = 0; a < 2; ++a)
#pragma unroll
            for (int b = 0; b < 2; ++b)
#pragma unroll
                for (int m = 0; m < 4; ++m)
#pragma unroll
                    for (int n = 0; n < 2; ++n) acc[a][b][m][n] = (f32x4){0.f, 0.f, 0.f, 0.f};
        }
        cur = nxt; cA = nA; cB = nB; ++ui;
        if constexpr (ALIGN_EPI) { if (wr == 1) PG8_BAR; }
    }
    PG8_WAIT_V(0);
    if constexpr (!ALIGN_EPI) { if (wr == 0) PG8_BAR; }
    PG8_BAR;
    if constexpr (Epi::AFTER_DRAIN) { E.fused(acc, cur, wr, wc, fr, fq, lds, wid, lane); S.done(cur); }
#undef PG8_SA
#undef PG8_SB
#undef PG8_STAGE
#undef PG8_LDA
#undef PG8_LDB
#undef PG8_MMA
#undef PG8_WAIT_V
#undef PG8_WAIT_L
#undef PG8_BAR
#undef PG8_SCHED
}
}

constexpr int NWAVES = 8;
constexpr int BATCH = 8, SEQ = 2048, D = 1024, M = BATCH * SEQ;
constexpr int NH = 24, HD = 64, AW = NH * HD  , AO = 512, PW = 512, DFF = 2816;
constexpr int NIN = PW + 3 * AW + 2 * D;
constexpr float RMS_EPS = 1e-6f;
#ifndef MK_N_LAUNCHES
#define MK_N_LAUNCHES 1
#endif
constexpr int NPH = 10;

constexpr size_t MiB = 1u << 20;
constexpr size_t WS_ROPE = 0;
constexpr size_t WS_W1 = 1 * MiB;
constexpr size_t WS_WPB = 15 * MiB, WS_WAB = 16 * MiB;
constexpr size_t WS_WOUT = 17 * MiB;
constexpr size_t WS_WGU = 19 * MiB;
constexpr size_t WS_WDN = 30 * MiB;
constexpr size_t WS_H = 36 * MiB;
constexpr size_t WS_Z = 68 * MiB;
constexpr size_t WS_Q = 84 * MiB, WS_K = 132 * MiB, WS_V = 180 * MiB;
constexpr size_t WS_LSE = 228 * MiB;
constexpr size_t WS_END = 230 * MiB;

#define LAS __attribute__((address_space(3)))
typedef unsigned short bf16;
typedef unsigned v4u __attribute__((ext_vector_type(4)));
typedef unsigned v2u __attribute__((ext_vector_type(2)));
typedef float f32x4 __attribute__((ext_vector_type(4)));
typedef float f32x16 __attribute__((ext_vector_type(16)));
typedef short bf16x8 __attribute__((ext_vector_type(8)));
typedef short s16x4 __attribute__((ext_vector_type(4)));
using pg8::cvtpk; using pg8::pack8; using pg8::unpack8;

constexpr int RING_BYTES = 131072;
constexpr int LDS_BYTES = 147456;

__device__ __forceinline__ float wave_sum(float v) {
#pragma unroll
    for (int o = 1; o < 64; o <<= 1) v += __shfl_xor(v, o);
    return v;
}

__device__ __forceinline__ void p0_transpose_item(const float* W, int K, int N, bf16* WT, int k0, int n0, int drow0, LAS float* scr, int lane) {
#pragma unroll 8
    for (int i = 0; i < 32; ++i) { const int kk = 2 * i + (lane >> 5); scr[kk * 33 + (lane & 31)] = W[(size_t)(k0 + kk) * N + n0 + (lane & 31)]; }
    asm volatile("s_waitcnt lgkmcnt(0)" ::: "memory");
    const int c = lane & 7;
#pragma unroll
    for (int j = 0; j < 4; ++j) { const int n = (lane >> 3) + 8 * j; const LAS float* s = scr + (8 * c) * 33 + n;
        v4u o; o.x = cvtpk(s[0 * 33], s[1 * 33]); o.y = cvtpk(s[2 * 33], s[3 * 33]); o.z = cvtpk(s[4 * 33], s[5 * 33]); o.w = cvtpk(s[6 * 33], s[7 * 33]);
        *(v4u*)(WT + (size_t)(drow0 + n) * K + k0 + 8 * c) = o; }
    asm volatile("s_waitcnt lgkmcnt(0)" ::: "memory");
}
__device__ __forceinline__ void sincos_d(double a, double& s, double& c) {
    const double kd = __builtin_rint(a * 0.63661977236758134308);
    double r = __builtin_fma(-kd, 1.57079632679489655800e+00, a); r = __builtin_fma(-kd, 6.12323399573676603587e-17, r);
    const double r2 = r * r;
    double sp = -1.0 / 1307674368000.0; sp = sp * r2 + 1.0 / 6227020800.0; sp = sp * r2 - 1.0 / 39916800.0; sp = sp * r2 + 1.0 / 362880.0; sp = sp * r2 - 1.0 / 5040.0; sp = sp * r2 + 1.0 / 120.0; sp = sp * r2 - 1.0 / 6.0; sp = sp * r2 + 1.0; sp *= r;
    double cp = 1.0 / 20922789888000.0; cp = cp * r2 - 1.0 / 87178291200.0; cp = cp * r2 + 1.0 / 479001600.0; cp = cp * r2 - 1.0 / 3628800.0; cp = cp * r2 + 1.0 / 40320.0; cp = cp * r2 - 1.0 / 720.0; cp = cp * r2 + 1.0 / 24.0; cp = cp * r2 - 0.5; cp = cp * r2 + 1.0;
    const int k = (int)kd & 3;
    s = (k == 0) ? sp : (k == 1) ? cp : (k == 2) ? -sp : -cp;
    c = (k == 0) ? cp : (k == 1) ? -sp : (k == 2) ? -cp : sp;
}
__device__ __forceinline__ void rms_row_to_bf16(const float* xrow, const float* g, bf16* orow, int lane) {
    f32x4 v[4];
    v[0] = *(const f32x4*)(xrow + 8 * lane); v[1] = *(const f32x4*)(xrow + 8 * lane + 4); v[2] = *(const f32x4*)(xrow + 512 + 8 * lane); v[3] = *(const f32x4*)(xrow + 512 + 8 * lane + 4);
    float s = 0.f;
#pragma unroll
    for (int j = 0; j < 4; ++j) s += (v[j][0] * v[j][0] + v[j][1] * v[j][1]) + (v[j][2] * v[j][2] + v[j][3] * v[j][3]);
    const float rs = 1.0f / sqrtf(wave_sum(s) * (1.0f / D) + RMS_EPS);
    const f32x4 g0 = *(const f32x4*)(g + 8 * lane), g1 = *(const f32x4*)(g + 8 * lane + 4), g2 = *(const f32x4*)(g + 512 + 8 * lane), g3 = *(const f32x4*)(g + 512 + 8 * lane + 4);
    *(v4u*)(orow + 8 * lane) = pack8(v[0] * rs * g0, v[1] * rs * g1);
    *(v4u*)(orow + 512 + 8 * lane) = pack8(v[2] * rs * g2, v[3] * rs * g3);
}

struct Args { const float* in[14]; float* out; unsigned char* ws; int ph_lo, ph_hi; };

__device__ __forceinline__ void p0_prologue(const Args& A, LAS unsigned char* lds, int wave, int lane, int gw, int NGW) {
    unsigned char* ws = A.ws;
    const float *x = A.in[0], *g_pre = A.in[1], *w_in = A.in[2], *w_grp = A.in[3], *pscale = A.in[4], *w_pbr = A.in[5], *w_abr = A.in[6], *w_out = A.in[7],
                *w_g = A.in[10], *w_u = A.in[11], *w_d = A.in[12];
    bf16 *W1 = (bf16*)(ws + WS_W1), *WPB = (bf16*)(ws + WS_WPB), *WAB = (bf16*)(ws + WS_WAB), *WOUT = (bf16*)(ws + WS_WOUT), *WGU = (bf16*)(ws + WS_WGU), *WDN = (bf16*)(ws + WS_WDN);
    LAS float* scr = (LAS float*)(lds + wave * 16384);
    constexpr int I_IN = 16 * 208, I_BR = 8 * 32, I_OUT = 16 * 32, I_GU = 16 * 88, I_DN = 44 * 32;
    constexpr int NT = I_IN + 2 * I_BR + I_OUT + 2 * I_GU + I_DN;
    for (int it = gw; it < NT; it += NGW) {
        int r = it;
        if (r < I_IN) { const int kb = r / 208, nb = 16 + r % 208, c = 32 * nb; int dr = c;
            if (c < 3584) { const int tb = c & ~255, g32 = (c & 255) >> 5; dr = tb + (g32 & 1) * 128 + (g32 >> 1) * 32; }
            p0_transpose_item(w_in, D, NIN, W1, 64 * kb, c, dr, scr, lane); continue; } r -= I_IN;
        if (r < I_BR) { p0_transpose_item(w_pbr, PW, D, WPB, 64 * (r / 32), 32 * (r % 32), 32 * (r % 32), scr, lane); continue; } r -= I_BR;
        if (r < I_BR) { p0_transpose_item(w_abr, AO, D, WAB, 64 * (r / 32), 32 * (r % 32), 32 * (r % 32), scr, lane); continue; } r -= I_BR;
        if (r < I_OUT) { p0_transpose_item(w_out, D, D, WOUT, 64 * (r / 32), 32 * (r % 32), 32 * (r % 32), scr, lane); continue; } r -= I_OUT;
        if (r < I_GU) { const int c = 32 * (r % 88); p0_transpose_item(w_g, D, DFF, WGU, 64 * (r / 88), c, 256 * (c >> 7) + (c & 127), scr, lane); continue; } r -= I_GU;
        if (r < I_GU) { const int c = 32 * (r % 88); p0_transpose_item(w_u, D, DFF, WGU, 64 * (r / 88), c, 256 * (c >> 7) + 128 + (c & 127), scr, lane); continue; } r -= I_GU;
        p0_transpose_item(w_d, DFF, D, WDN, 64 * (r / 32), 32 * (r % 32), 32 * (r % 32), scr, lane);
    }
    for (int it = gw; it < 512; it += NGW) {
        const int g = it >> 7, kb = (it >> 1) & 63, jh = it & 1, k0 = 16 * kb, j = jh * 64 + lane;
#pragma unroll
        for (int i = 0; i < 16; ++i) { const float* src = w_in + (size_t)(k0 + i) * NIN + g * 128 + 2 * lane; scr[i * 128 + 2 * lane] = src[0]; scr[i * 128 + 2 * lane + 1] = src[1]; }
        asm volatile("s_waitcnt lgkmcnt(0)" ::: "memory");
        float acc[16];
#pragma unroll
        for (int i = 0; i < 16; ++i) acc[i] = 0.f;
        const float* wg = w_grp + (size_t)g * 128 * 128 + j;
        for (int c = 0; c < 128; c += 4) {
            const float w0 = wg[(c + 0) * 128], w1 = wg[(c + 1) * 128], w2 = wg[(c + 2) * 128], w3 = wg[(c + 3) * 128];
#pragma unroll
            for (int i = 0; i < 16; ++i) { const f32x4 a = *(const LAS f32x4*)(scr + i * 128 + c); acc[i] += a[0] * w0 + a[1] * w1 + a[2] * w2 + a[3] * w3; }
        }
        const float sc = pscale[g * 128 + j];
        bf16* dst = W1 + (size_t)(g * 128 + j) * D + k0;
        v4u o0, o1;
        o0.x = cvtpk(acc[0] * sc, acc[1] * sc); o0.y = cvtpk(acc[2] * sc, acc[3] * sc); o0.z = cvtpk(acc[4] * sc, acc[5] * sc); o0.w = cvtpk(acc[6] * sc, acc[7] * sc);
        o1.x = cvtpk(acc[8] * sc, acc[9] * sc); o1.y = cvtpk(acc[10] * sc, acc[11] * sc); o1.z = cvtpk(acc[12] * sc, acc[13] * sc); o1.w = cvtpk(acc[14] * sc, acc[15] * sc);
        *(v4u*)dst = o0; *(v4u*)(dst + 8) = o1;
        asm volatile("s_waitcnt lgkmcnt(0)" ::: "memory");
    }
    float* rope = (float*)(ws + WS_ROPE);
    for (int e = gw * 64 + lane; e < 2048 * 32; e += NGW * 64) {
        const int pos = e >> 5, f = e & 31;
        const float inv = (float)exp2(-(double)f * (13.287712379549449 / 32.0));
        const float ang = (float)pos * inv;
        double s, c; sincos_d((double)ang, s, c);
        rope[pos * 64 + f] = (float)c; rope[pos * 64 + 32 + f] = (float)s;
    }
    bf16* H = (bf16*)(ws + WS_H);
    for (int m = gw; m < M; m += NGW) rms_row_to_bf16(x + (size_t)m * D, g_pre, H + (size_t)m * D, lane);
}

__device__ __forceinline__ int crow(int r, int hi) { return (r & 3) + 8 * (r >> 2) + 4 * hi; }
__device__ __forceinline__ void att_decode(int u, int& b, int& h, int& dsh, int& r, int& qb) {
    const int qbg = u & 63; h = (u >> 6) % NH; b = u / (64 * NH); dsh = (h >> 3) * 2; r = qbg >> (6 - dsh); qb = qbg & ((64 >> dsh) - 1);
}
__device__ __forceinline__ void att_load_kq(int u, const bf16* Q, const bf16* K, int q, int hi, bf16x8 (&kf)[5][4], bf16x8 (&qf)[4]) {
    int b, h, dsh, r, qb; att_decode(u, b, h, dsh, r, qb);
    const int L = SEQ >> dsh;
    const bf16* qp = Q + ((size_t)b * SEQ + ((size_t)(32 * qb + q) << dsh) + r) * AW + h * 64 + hi * 32;
#pragma unroll
    for (int d0 = 0; d0 < 4; ++d0) qf[d0] = *(const bf16x8*)(qp + d0 * 8);
#pragma unroll
    for (int T = 0; T < 5; ++T) { int lk = 32 * qb - 64 + 32 * T + q; lk = lk < 0 ? 0 : (lk > L - 1 ? L - 1 : lk);
        const bf16* kp = K + ((size_t)b * SEQ + ((size_t)lk << dsh) + r) * AW + h * 64 + hi * 32;
#pragma unroll
        for (int d0 = 0; d0 < 4; ++d0) kf[T][d0] = *(const bf16x8*)(kp + d0 * 8); }
}
__device__ __forceinline__ v4u att_load_v(const bf16* V, int b, int h, int dsh, int r, int qb, int L, int T, int pc, int lane) {
    int lk = 32 * qb - 64 + 32 * T + 8 * pc + (lane >> 3); lk = lk < 0 ? 0 : (lk > L - 1 ? L - 1 : lk);
    return *(const v4u*)(V + ((size_t)b * SEQ + ((size_t)lk << dsh) + r) * AW + h * 64 + (lane & 7) * 8);
}
__device__ __forceinline__ s16x4 vtr(const LAS unsigned char* p) { typedef short v4i16_t __attribute__((ext_vector_type(4))); return __builtin_bit_cast(s16x4, __builtin_amdgcn_ds_read_tr16_b64_v4i16((LAS v4i16_t*)p)); }

__device__ __forceinline__ void attn_phase(LAS unsigned char* lds, bf16* QO, const bf16* Kb, const bf16* Vb, float* LSE, int wave, int lane, int gw, int NGW) {
    constexpr int NU = BATCH * NH * 64;
    const int q = lane & 31, hi = lane >> 5;
    LAS unsigned char* vl = lds + wave * 16384;
    const int vw0 = (lane >> 3) * 128 + (((lane & 7) * 16) ^ (((lane >> 4) & 1) << 6));
    const int q4 = (lane & 15) >> 2, p4 = lane & 3, gsel = (lane >> 4) & 1, bsw = (q4 >> 1) & 1;
    const int tr0 = (4 * hi + q4) * 128 + ((0 ^ bsw) << 6) + 32 * gsel + 8 * p4;
    const int tr1 = (4 * hi + q4) * 128 + ((1 ^ bsw) << 6) + 32 * gsel + 8 * p4;
    bf16x8 kf[5][4], qf[4];
    int u = gw;
#ifdef ATT_PREFETCH
    if (u < NU) att_load_kq(u, QO, Kb, q, hi, kf, qf);
#endif
    for (; u < NU; u += NGW) {
        int b, h, dsh, r, qb; att_decode(u, b, h, dsh, r, qb);
#ifndef ATT_PREFETCH
        att_load_kq(u, QO, Kb, q, hi, kf, qf);
#endif
        const int L = SEQ >> dsh;
        f32x16 s[5];
#pragma unroll
        for (int T = 0; T < 5; ++T) { s[T] = (f32x16){0.f, 0.f, 0.f, 0.f, 0.f, 0.f, 0.f, 0.f, 0.f, 0.f, 0.f, 0.f, 0.f, 0.f, 0.f, 0.f};
#pragma unroll
            for (int d0 = 0; d0 < 4; ++d0) s[T] = __builtin_amdgcn_mfma_f32_32x32x16_bf16(kf[T][d0], qf[d0], s[T], 0, 0, 0); }
        __builtin_amdgcn_sched_barrier(0);
        v4u vr[3][4];
#pragma unroll
        for (int T = 0; T < 3; ++T)
#pragma unroll
            for (int pc = 0; pc < 4; ++pc) vr[T][pc] = att_load_v(Vb, b, h, dsh, r, qb, L, T, pc, lane);
        __builtin_amdgcn_sched_barrier(0);
        float mx = -INFINITY;
#pragma unroll
        for (int T = 0; T < 5; ++T)
#pragma unroll
            for (int i = 0; i < 16; ++i) { const int kk = crow(i, hi), rel = 32 * T + kk - 64 - q, lk = 32 * qb - 64 + 32 * T + kk;
                const bool ok = (rel >= -64) && (rel <= 64) && (lk >= 0) && (lk < L);
                s[T][i] = ok ? s[T][i] : -INFINITY; mx = fmaxf(mx, s[T][i]); }
        mx = fmaxf(mx, __shfl_xor(mx, 32));
        float sum = 0.f;
#pragma unroll
        for (int T = 0; T < 5; ++T)
#pragma unroll
            for (int i = 0; i < 16; ++i) { const float p = __builtin_amdgcn_exp2f(s[T][i] - mx); s[T][i] = p; sum += p; }
        sum += __shfl_xor(sum, 32);
        bf16x8 pw[5][2];
#pragma unroll
        for (int T = 0; T < 5; ++T)
#pragma unroll
            for (int s2 = 0; s2 < 2; ++s2) { v4u w; w.x = cvtpk(s[T][8 * s2 + 0], s[T][8 * s2 + 1]); w.y = cvtpk(s[T][8 * s2 + 2], s[T][8 * s2 + 3]); w.z = cvtpk(s[T][8 * s2 + 4], s[T][8 * s2 + 5]); w.w = cvtpk(s[T][8 * s2 + 6], s[T][8 * s2 + 7]);
                pw[T][s2] = __builtin_bit_cast(bf16x8, w); }
        asm volatile("" ::: "memory"); __builtin_amdgcn_sched_barrier(0);
#pragma unroll
        for (int T = 0; T < 3; ++T)
#pragma unroll
            for (int pc = 0; pc < 4; ++pc) *(LAS v4u*)(vl + T * 4096 + pc * 1024 + vw0) = vr[T][pc];
        v4u vr2[2][4];
#pragma unroll
        for (int T = 0; T < 2; ++T)
#pragma unroll
            for (int pc = 0; pc < 4; ++pc) vr2[T][pc] = att_load_v(Vb, b, h, dsh, r, qb, L, 3 + T, pc, lane);
        asm volatile("" ::: "memory");
        f32x16 o[2];
        o[0] = (f32x16){0.f, 0.f, 0.f, 0.f, 0.f, 0.f, 0.f, 0.f, 0.f, 0.f, 0.f, 0.f, 0.f, 0.f, 0.f, 0.f}; o[1] = o[0];
#define ATT_PV(T, slot) do { _Pragma("unroll") for (int s2 = 0; s2 < 2; ++s2) { \
            const LAS unsigned char* b0_ = vl + (slot) * 4096 + s2 * 2048; \
            const s16x4 a00 = vtr(b0_ + tr0), a01 = vtr(b0_ + 1024 + tr0), a10 = vtr(b0_ + tr1), a11 = vtr(b0_ + 1024 + tr1); \
            const bf16x8 v0_ = (bf16x8){a00[0], a00[1], a00[2], a00[3], a01[0], a01[1], a01[2], a01[3]}; \
            const bf16x8 v1_ = (bf16x8){a10[0], a10[1], a10[2], a10[3], a11[0], a11[1], a11[2], a11[3]}; \
            o[0] = __builtin_amdgcn_mfma_f32_32x32x16_bf16(v0_, pw[T][s2], o[0], 0, 0, 0); \
            o[1] = __builtin_amdgcn_mfma_f32_32x32x16_bf16(v1_, pw[T][s2], o[1], 0, 0, 0); } } while (0)
        __builtin_amdgcn_sched_barrier(0);
        ATT_PV(0, 0); ATT_PV(1, 1); ATT_PV(2, 2);
        asm volatile("" ::: "memory"); __builtin_amdgcn_sched_barrier(0);
#pragma unroll
        for (int T = 0; T < 2; ++T)
#pragma unroll
            for (int pc = 0; pc < 4; ++pc) *(LAS v4u*)(vl + T * 4096 + pc * 1024 + vw0) = vr2[T][pc];
        asm volatile("" ::: "memory");
        __builtin_amdgcn_sched_barrier(0);
#ifdef ATT_PREFETCH
        const int un = u + NGW;
        if (un < NU) att_load_kq(un, QO, Kb, q, hi, kf, qf);
#endif
        __builtin_amdgcn_sched_barrier(0);
        ATT_PV(3, 0); ATT_PV(4, 1);
        asm volatile("" ::: "memory"); __builtin_amdgcn_sched_barrier(0);
#undef ATT_PV
        const float rl = 1.0f / sum;
        const size_t row = (size_t)b * SEQ + ((size_t)(32 * qb + q) << dsh) + r;
        bf16* op = QO + row * AW + h * 64 + 4 * hi;
#pragma unroll
        for (int dh = 0; dh < 2; ++dh)
#pragma unroll
            for (int rg = 0; rg < 4; ++rg) { v2u w; w.x = cvtpk(o[dh][4 * rg + 0] * rl, o[dh][4 * rg + 1] * rl); w.y = cvtpk(o[dh][4 * rg + 2] * rl, o[dh][4 * rg + 3] * rl);
                *(v2u*)(op + 32 * dh + 8 * rg) = w; }
        if (hi == 0) LSE[row * NH + h] = (mx + __builtin_log2f(sum)) * 0.6931471805599453f;
    }
}

__device__ __forceinline__ void merge_pool_phase(const bf16* O3, const float* LSE, const bf16* Z, bf16* PM, bf16* OATT, int lane, int gw, int NGW) {
    for (int row = gw; row < M; row += NGW) {
        {
            const int hs = lane >> 3, dc = (lane & 7) * 8;
            const float l0 = LSE[(size_t)row * NH + hs], l1 = LSE[(size_t)row * NH + 8 + hs], l2 = LSE[(size_t)row * NH + 16 + hs];
            const float mx = fmaxf(l0, fmaxf(l1, l2));
            float e0 = __expf(l0 - mx), e1 = __expf(l1 - mx), e2 = __expf(l2 - mx);
            const float inv = 1.0f / (e0 + e1 + e2); e0 *= inv; e1 *= inv; e2 *= inv;
            const bf16* op = O3 + (size_t)row * AW + hs * 64 + dc;
            f32x4 a0, a1, b0, b1, c0, c1;
            unpack8(*(const v4u*)op, a0, a1); unpack8(*(const v4u*)(op + 512), b0, b1); unpack8(*(const v4u*)(op + 1024), c0, c1);
            *(v4u*)(OATT + (size_t)row * AO + hs * 64 + dc) = pack8(a0 * e0 + b0 * e1 + c0 * e2, a1 * e0 + b1 * e1 + c1 * e2);
        }
        {
            const int t = row & (SEQ - 1), rad = 1 << (lane >> 4);
            int lo = t - rad; lo = lo < 0 ? 0 : lo; int hi_ = t + rad + 1; hi_ = hi_ > SEQ ? SEQ : hi_;
            const bf16* zp = Z + (size_t)row * PW + 8 * lane;
            f32x4 s0 = (f32x4){0.f, 0.f, 0.f, 0.f}, s1 = s0, c0 = s0, c1 = s0;
#pragma unroll
            for (int off = -8; off <= 8; ++off) { const int tt = t + off;
                if (tt >= lo && tt < hi_) { f32x4 a0, a1; unpack8(*(const v4u*)(zp + (ptrdiff_t)off * PW), a0, a1); s0 += a0; s1 += a1; if (off == 0) { c0 = a0; c1 = a1; } } }
            const float ic = 1.0f / (float)(hi_ - lo);
            *(v4u*)(PM + (size_t)row * PW + 8 * lane) = pack8(s0 * ic - c0, s1 * ic - c1);
        }
    }
}

__device__ __forceinline__ void rows_mid(const float* x, const bf16* MIX, const float* gpost, const float* gpre2, float* X1, bf16* H2, int lane, int gw, int NGW) {
    for (int row = gw; row < M; row += NGW) {
        const bf16* mp = MIX + (size_t)row * D; const float* xp = x + (size_t)row * D; float* x1p = X1 + (size_t)row * D;
        f32x4 mv[4], xv[4];
        unpack8(*(const v4u*)(mp + 8 * lane), mv[0], mv[1]); unpack8(*(const v4u*)(mp + 512 + 8 * lane), mv[2], mv[3]);
        xv[0] = *(const f32x4*)(xp + 8 * lane); xv[1] = *(const f32x4*)(xp + 8 * lane + 4); xv[2] = *(const f32x4*)(xp + 512 + 8 * lane); xv[3] = *(const f32x4*)(xp + 512 + 8 * lane + 4);
        float s = 0.f;
#pragma unroll
        for (int j = 0; j < 4; ++j) s += (mv[j][0] * mv[j][0] + mv[j][1] * mv[j][1]) + (mv[j][2] * mv[j][2] + mv[j][3] * mv[j][3]);
        const float rs = 1.0f / sqrtf(wave_sum(s) * (1.0f / D) + RMS_EPS);
        float s2 = 0.f;
#pragma unroll
        for (int j = 0; j < 4; ++j) { const int c = (j >> 1) * 512 + 8 * lane + (j & 1) * 4; const f32x4 g = *(const f32x4*)(gpost + c);
            xv[j] = xv[j] + mv[j] * rs * g; *(f32x4*)(x1p + c) = xv[j];
            s2 += (xv[j][0] * xv[j][0] + xv[j][1] * xv[j][1]) + (xv[j][2] * xv[j][2] + xv[j][3] * xv[j][3]); }
        const float rs2 = 1.0f / sqrtf(wave_sum(s2) * (1.0f / D) + RMS_EPS);
        const f32x4 g0 = *(const f32x4*)(gpre2 + 8 * lane), g1 = *(const f32x4*)(gpre2 + 8 * lane + 4), g2 = *(const f32x4*)(gpre2 + 512 + 8 * lane), g3 = *(const f32x4*)(gpre2 + 512 + 8 * lane + 4);
        *(v4u*)(H2 + (size_t)row * D + 8 * lane) = pack8(xv[0] * rs2 * g0, xv[1] * rs2 * g1);
        *(v4u*)(H2 + (size_t)row * D + 512 + 8 * lane) = pack8(xv[2] * rs2 * g2, xv[3] * rs2 * g3);
    }
}
__device__ __forceinline__ void rows_final(const bf16* Fb, const float* gpost2, float* X1, int lane, int gw, int NGW) {
    for (int row = gw; row < M; row += NGW) {
        const bf16* fp = Fb + (size_t)row * D; float* x1p = X1 + (size_t)row * D;
        f32x4 fv[4];
        unpack8(*(const v4u*)(fp + 8 * lane), fv[0], fv[1]); unpack8(*(const v4u*)(fp + 512 + 8 * lane), fv[2], fv[3]);
        float s = 0.f;
#pragma unroll
        for (int j = 0; j < 4; ++j) s += (fv[j][0] * fv[j][0] + fv[j][1] * fv[j][1]) + (fv[j][2] * fv[j][2] + fv[j][3] * fv[j][3]);
        const float rs = 1.0f / sqrtf(wave_sum(s) * (1.0f / D) + RMS_EPS);
#pragma unroll
        for (int j = 0; j < 4; ++j) { const int c = (j >> 1) * 512 + 8 * lane + (j & 1) * 4; const f32x4 g = *(const f32x4*)(gpost2 + c);
            *(f32x4*)(x1p + c) = *(const f32x4*)(x1p + c) + fv[j] * rs * g; }
    }
}

__global__ void __launch_bounds__(NWAVES * 64, 2) fwd_megakernel(Args args) {
    extern __shared__ __attribute__((aligned(16))) unsigned char lds_raw[];
    LAS unsigned char* lds = (LAS unsigned char*)lds_raw;
    const int tid = threadIdx.x, lane = tid & 63, wave = __builtin_amdgcn_readfirstlane(tid >> 6);
    const int G = gridDim.x, gw = blockIdx.x * NWAVES + wave, NGW = G * NWAVES;
    unsigned char* ws = args.ws;
    bf16 *W1 = (bf16*)(ws + WS_W1), *WPB = (bf16*)(ws + WS_WPB), *WAB = (bf16*)(ws + WS_WAB), *WOUT = (bf16*)(ws + WS_WOUT), *WGU = (bf16*)(ws + WS_WGU), *WDN = (bf16*)(ws + WS_WDN);
    bf16 *HB = (bf16*)(ws + WS_H), *ZB = (bf16*)(ws + WS_Z), *QB = (bf16*)(ws + WS_Q), *KB = (bf16*)(ws + WS_K), *VB = (bf16*)(ws + WS_V);
    bf16 *PMB = (bf16*)(ws + WS_K), *OATT = (bf16*)(ws + WS_K + 16 * MiB), *GATED = (bf16*)(ws + WS_V), *MIXB = (bf16*)(ws + WS_H), *H2 = (bf16*)(ws + WS_V), *ACT = (bf16*)(ws + WS_Q), *FB = (bf16*)(ws + WS_H);
    bf16 *SGP = (bf16*)args.out, *SGA = SGP + (size_t)M * D;
    float* LSE = (float*)(ws + WS_LSE); const float* rope = (const float*)(ws + WS_ROPE);
    const int lo = args.ph_lo, hi = args.ph_hi;
#ifndef PH_MASK
#define PH_MASK 0x3ff
#endif
#define IN(k) (lo <= (k) && (k) < hi && ((PH_MASK >> (k)) & 1))
#define SEAM(k) do { if (IN(k) && IN((k) + 1)) cg::this_grid().sync(); } while (0)

    if (IN(0)) { p0_prologue(args, lds, wave, lane, gw, NGW); __syncthreads(); }
    SEAM(0);
    if (IN(1)) {
        pg8::Gemm g{HB, W1, nullptr, nullptr, M, NIN, D}; pg8::StaticOrder S; S.init(M, NIN, G, (int)blockIdx.x);
        pg8::EpiProj E{ZB, QB, KB, VB, SGP, SGA, rope};
        pg8::gemm_phase<pg8::EpiProj, pg8::StaticOrder, true, true>(lds, g, S, E);
    }
    SEAM(1);
    if (IN(2)) { attn_phase(lds, QB, KB, VB, LSE, wave, lane, gw, NGW); __syncthreads(); }
    SEAM(2);
    if (IN(3)) merge_pool_phase(QB, LSE, ZB, PMB, OATT, lane, gw, NGW);
    SEAM(3);
    if (IN(4)) {
        pg8::Gemm g{PMB, WPB, OATT, WAB, M, D, PW}; pg8::PairOrder S; S.S.init(M, D, G, (int)blockIdx.x);
        pg8::EpiGate E{SGP, SGA, GATED};
        pg8::gemm_phase<pg8::EpiGate, pg8::PairOrder, true, true>(lds, g, S, E);
    }
    SEAM(4);
    if (IN(5)) {
        pg8::Gemm g{GATED, WOUT, nullptr, nullptr, M, D, D}; pg8::StaticOrder S; S.init(M, D, G, (int)blockIdx.x);
        pg8::EpiPlain E{MIXB, D};
        pg8::gemm_phase<pg8::EpiPlain, pg8::StaticOrder, true, true>(lds, g, S, E);
    }
    SEAM(5);
    if (IN(6)) rows_mid(args.in[0], MIXB, args.in[8], args.in[9], args.out, H2, lane, gw, NGW);
    SEAM(6);
    if (IN(7)) {
        pg8::Gemm g{H2, WGU, nullptr, nullptr, M, 2 * DFF, D}; pg8::StaticOrder S; S.init(M, 2 * DFF, G, (int)blockIdx.x);
        pg8::EpiSwiGLU E{ACT, DFF};
        pg8::gemm_phase<pg8::EpiSwiGLU, pg8::StaticOrder, true, true>(lds, g, S, E);
    }
    SEAM(7);
    if (IN(8)) {
        pg8::Gemm g{ACT, WDN, nullptr, nullptr, M, D, DFF}; pg8::StaticOrder S; S.init(M, D, G, (int)blockIdx.x);
        pg8::EpiPlain E{FB, D};
        pg8::gemm_phase<pg8::EpiPlain, pg8::StaticOrder, true, true>(lds, g, S, E);
    }
    SEAM(8);
    if (IN(9)) rows_final(FB, args.in[13], args.out, lane, gw, NGW);
#undef IN
#undef SEAM
}

extern "C" void kernel_launch(void* const* d_in, const int* in_sizes, int n_in, void* d_out, int out_size, void* d_ws, size_t ws_size, hipStream_t stream) {
    static int grid = 0;
    if (grid == 0) {
        if (n_in != 14 || in_sizes[0] != M * D || out_size != M * D || ws_size < WS_END) { fprintf(stderr, "kernel_launch: unexpected shapes (n_in %d, in0 %d, out %d, ws %zu)\n", n_in, n_in > 0 ? in_sizes[0] : -1, out_size, ws_size); grid = -1; return; }
        int dev = 0, cus = 0, per_cu = 0;
        if (hipGetDevice(&dev) != hipSuccess || hipDeviceGetAttribute(&cus, hipDeviceAttributeMultiprocessorCount, dev) != hipSuccess) { grid = -1; return; }
        if (hipFuncSetAttribute((const void*)fwd_megakernel, hipFuncAttributeMaxDynamicSharedMemorySize, LDS_BYTES) != hipSuccess) { fprintf(stderr, "kernel_launch: hipFuncSetAttribute failed\n"); grid = -1; return; }
        if (hipOccupancyMaxActiveBlocksPerMultiprocessor(&per_cu, (const void*)fwd_megakernel, NWAVES * 64, LDS_BYTES) != hipSuccess || per_cu < 1) { fprintf(stderr, "kernel_launch: occupancy query says %d blocks per CU\n", per_cu); per_cu = 1; }
        (void)hipGetLastError();
        grid = cus * 1;
    }
    if (grid < 0) return;
    Args a{};
    for (int i = 0; i < 14; ++i) a.in[i] = (const float*)d_in[i];
    a.out = (float*)d_out; a.ws = (unsigned char*)d_ws;
#if MK_N_LAUNCHES == 1
    a.ph_lo = 0; a.ph_hi = NPH;
    void* kargs[] = {&a};
    hipError_t e = hipLaunchCooperativeKernel((const void*)fwd_megakernel, dim3(grid), dim3(NWAVES * 64), kargs, LDS_BYTES, stream);
    if (e != hipSuccess) fprintf(stderr, "kernel_launch: cooperative launch failed: %s (grid %d)\n", hipGetErrorString(e), grid);
#else
    for (int p = 0; p < NPH; ++p) { a.ph_lo = p; a.ph_hi = p + 1; hipLaunchKernelGGL(fwd_megakernel, dim3(grid), dim3(NWAVES * 64), LDS_BYTES, stream, a); }
#endif
}
```

```cpp
#include <hip/hip_runtime.h>
#include <hip/hip_cooperative_groups.h>
#include <cstdio>
#include <cstdint>
namespace cg = cooperative_groups;

namespace pg8 {
#define PG8_LAS __attribute__((address_space(3)))
typedef unsigned short bf16_t;
typedef short bf16x8 __attribute__((ext_vector_type(8)));
typedef float f32x4 __attribute__((ext_vector_type(4)));
typedef unsigned u32x4 __attribute__((ext_vector_type(4)));
constexpr int BM = 256, BK = 64, HALF = 128, HTB = HALF * BK * 2  , STAGE_BYTES = 8 * HTB, NXCD = 8, WGM = 8;

__host__ __device__ __forceinline__ int lds_byte(int r, int c) { const int st = (r >> 4) * 2 + (c >> 5), rr = r & 15, cc = c & 31, ob = rr * 64 + cc * 2; return st * 1024 + (ob ^ (((ob >> 9) & 1) << 5)); }
__host__ __device__ __forceinline__ void stage_rc(int b, int& R, int& C) { const int st = b / 1024, sb = b % 1024, swz = sb ^ (((sb >> 9) & 1) << 5); R = (st >> 1) * 16 + swz / 64; C = (st & 1) * 32 + (swz % 64) / 2; }
__host__ __device__ __forceinline__ int perm32(int rho) { const int n = rho >> 4, i = rho & 15; return 8 * (i >> 2) + 4 * n + (i & 3); }

struct Unit { int pm, pn, src; };
struct Gemm { const bf16_t* A; const bf16_t* Bt; const bf16_t* A2; const bf16_t* Bt2; int M, N, K; };

struct StaticOrder {
    int nM, nN, nwg, G, c;
    __host__ __device__ void init(int M, int N, int G_, int c_) { nM = M / BM; nN = N / BM; nwg = nM * nN; G = G_; c = c_; }
    __host__ __device__ bool next(int i, Unit& u) const {
        const long L = (long)i * G + c; if (L >= nwg) return false;
        int wgid = (int)L; { const int q = nwg / NXCD, r = nwg % NXCD, xcd = wgid % NXCD, off = wgid / NXCD; wgid = (xcd < r ? xcd * (q + 1) : r * (q + 1) + (xcd - r) * q) + off; }
        const int nig = WGM * nN, gid = wgid / nig, fm = gid * WGM, gsz = (nM - fm) < WGM ? (nM - fm) : WGM;
        u.pm = fm + ((wgid % nig) % gsz); u.pn = (wgid % nig) / gsz; u.src = 0; return true;
    }
    __device__ __forceinline__ void a_ready(const Unit&) const {}
    __device__ __forceinline__ void done(const Unit&) const {}
};


typedef float f32x2v __attribute__((ext_vector_type(2)));
typedef __bf16 bf16x2v __attribute__((ext_vector_type(2)));
__device__ __forceinline__ unsigned cvtpk(float lo, float hi) { f32x2v v = {lo, hi}; bf16x2v b = __builtin_convertvector(v, bf16x2v); return __builtin_bit_cast(unsigned, b); }
__device__ __forceinline__ u32x4 pack8(f32x4 a, f32x4 b) { u32x4 w; w.x = cvtpk(a[0], a[1]); w.y = cvtpk(a[2], a[3]); w.z = cvtpk(b[0], b[1]); w.w = cvtpk(b[2], b[3]); return w; }
__device__ __forceinline__ void unpack8(u32x4 w, f32x4& a, f32x4& b) {
    a[0] = __uint_as_float(w.x << 16); a[1] = __uint_as_float(w.x & 0xffff0000u); a[2] = __uint_as_float(w.y << 16); a[3] = __uint_as_float(w.y & 0xffff0000u);
    b[0] = __uint_as_float(w.z << 16); b[1] = __uint_as_float(w.z & 0xffff0000u); b[2] = __uint_as_float(w.w << 16); b[3] = __uint_as_float(w.w & 0xffff0000u); }
__device__ __forceinline__ float sigmoidf_(float v) { return __builtin_amdgcn_rcpf(1.0f + __expf(-v)); }
__device__ __forceinline__ f32x4 sigmoid4(f32x4 v) { f32x4 o; o[0] = sigmoidf_(v[0]); o[1] = sigmoidf_(v[1]); o[2] = sigmoidf_(v[2]); o[3] = sigmoidf_(v[3]); return o; }

constexpr float ATT_C2 = 0.125f * 1.4426950408889634f;

struct EpiProj {
    static constexpr bool PERM = true, AFTER_DRAIN = false, CHAIN = false;
    bf16_t *Z, *Q, *Kb, *V, *SGP, *SGA; const float* rope;
    __device__ __forceinline__ void operator()(f32x4 (&acc)[2][2][4][2], const Unit& u, int wr, int wc, int fr, int fq) const {
        const int pn = u.pn; const int row0 = u.pm * BM + wr * 64 + fr;
        if (pn >= 2 && pn < 14) {
            bf16_t* base; int tile; float sc;
            if (pn < 8) { base = Q; tile = pn - 2; sc = ATT_C2; } else { base = Kb; tile = pn - 8; sc = 1.0f; }
            const int col0 = tile * 256 + wc * 64 + 8 * fq;
#pragma unroll
            for (int ai = 0; ai < 2; ++ai)
#pragma unroll
                for (int m = 0; m < 4; ++m) {
                    const int row = row0 + ai * HALF + m * 16; const float* cp = rope + (size_t)(row & 2047) * 64 + 8 * fq;
                    const f32x4 c0 = *(const f32x4*)cp, c1 = *(const f32x4*)(cp + 4), s0 = *(const f32x4*)(cp + 32), s1 = *(const f32x4*)(cp + 36);
                    const f32x4 a0 = acc[ai][0][m][0], a1 = acc[ai][0][m][1], b0 = acc[ai][1][m][0], b1 = acc[ai][1][m][1];
                    const f32x4 lo0 = (a0 * c0 - b0 * s0) * sc, lo1 = (a1 * c1 - b1 * s1) * sc, hi0 = (b0 * c0 + a0 * s0) * sc, hi1 = (b1 * c1 + a1 * s1) * sc;
                    bf16_t* rp = base + (size_t)row * 1536 + col0;
                    *(u32x4*)rp = pack8(lo0, lo1); *(u32x4*)(rp + 32) = pack8(hi0, hi1);
                }
        } else {
            bf16_t* base; int ldc, colb; bool sg = false;
            if (pn < 2) { base = Z; ldc = 512; colb = pn * 256; }
            else if (pn < 20) { base = V; ldc = 1536; colb = (pn - 14) * 256; }
            else if (pn < 24) { base = SGP; ldc = 1024; colb = (pn - 20) * 256; sg = true; }
            else { base = SGA; ldc = 1024; colb = (pn - 24) * 256; sg = true; }
            const int col0 = colb + wc * 32 + 8 * fq;
#pragma unroll
            for (int ai = 0; ai < 2; ++ai)
#pragma unroll
                for (int m = 0; m < 4; ++m) { bf16_t* rp = base + (size_t)(row0 + ai * HALF + m * 16) * ldc + col0;
#pragma unroll
                    for (int bj = 0; bj < 2; ++bj) { f32x4 v0 = acc[ai][bj][m][0], v1 = acc[ai][bj][m][1];
                        if (sg) { v0 = sigmoid4(v0); v1 = sigmoid4(v1); }
                        *(u32x4*)(rp + bj * HALF) = pack8(v0, v1); } }
        }
    }
};
struct EpiPlain {
    static constexpr bool PERM = true, AFTER_DRAIN = false, CHAIN = false;
    bf16_t* O; int ldc;
    __device__ __forceinline__ void operator()(f32x4 (&acc)[2][2][4][2], const Unit& u, int wr, int wc, int fr, int fq) const {
        const int row0 = u.pm * BM + wr * 64 + fr, col0 = u.pn * BM + wc * 32 + 8 * fq;
#pragma unroll
        for (int ai = 0; ai < 2; ++ai)
#pragma unroll
            for (int m = 0; m < 4; ++m) { bf16_t* rp = O + (size_t)(row0 + ai * HALF + m * 16) * ldc + col0;
#pragma unroll
                for (int bj = 0; bj < 2; ++bj) *(u32x4*)(rp + bj * HALF) = pack8(acc[ai][bj][m][0], acc[ai][bj][m][1]); }
    }
};
struct EpiGate {
    static constexpr bool PERM = true, AFTER_DRAIN = false, CHAIN = true;
    const bf16_t *SGP, *SGA; bf16_t* O;
    __device__ __forceinline__ void operator()(f32x4 (&acc)[2][2][4][2], const Unit& u, int wr, int wc, int fr, int fq) const {
        const int row0 = u.pm * BM + wr * 64 + fr, col0 = u.pn * BM + wc * 32 + 8 * fq;
#pragma unroll
        for (int ai = 0; ai < 2; ++ai)
#pragma unroll
            for (int m = 0; m < 4; ++m) { const size_t off = (size_t)(row0 + ai * HALF + m * 16) * 1024 + col0;
#pragma unroll
                for (int bj = 0; bj < 2; ++bj) {
                    f32x4 a0, a1; unpack8(*(const u32x4*)(SGA + off + bj * HALF), a0, a1);
                    if (u.src == 0) {
                        f32x4 p0, p1; unpack8(*(const u32x4*)(SGP + off + bj * HALF), p0, p1);
#pragma unroll
                        for (int i = 0; i < 4; ++i) { acc[ai][bj][m][0][i] *= p0[i] * __builtin_amdgcn_rcpf(a0[i]); acc[ai][bj][m][1][i] *= p1[i] * __builtin_amdgcn_rcpf(a1[i]); }
                    } else {
                        *(u32x4*)(O + off + bj * HALF) = pack8(acc[ai][bj][m][0] * a0, acc[ai][bj][m][1] * a1);
                    } } }
    }
};
struct EpiSwiGLU {
    static constexpr bool PERM = true, AFTER_DRAIN = false, CHAIN = false;
    bf16_t* O; int ldc;
    __device__ __forceinline__ void operator()(f32x4 (&acc)[2][2][4][2], const Unit& u, int wr, int wc, int fr, int fq) const {
        const int row0 = u.pm * BM + wr * 64 + fr, col0 = u.pn * HALF + wc * 32 + 8 * fq;
#pragma unroll
        for (int ai = 0; ai < 2; ++ai)
#pragma unroll
            for (int m = 0; m < 4; ++m) {
                const f32x4 g0 = acc[ai][0][m][0], g1 = acc[ai][0][m][1], u0 = acc[ai][1][m][0], u1 = acc[ai][1][m][1];
                const f32x4 r0 = g0 * sigmoid4(g0) * u0, r1 = g1 * sigmoid4(g1) * u1;
                *(u32x4*)(O + (size_t)(row0 + ai * HALF + m * 16) * ldc + col0) = pack8(r0, r1); }
    }
};
struct PairOrder {
    StaticOrder S;
    __device__ bool next(int i, Unit& u) const { if (!S.next(i >> 1, u)) return false; u.src = i & 1; return true; }
    __device__ __forceinline__ void a_ready(const Unit&) const {}
    __device__ __forceinline__ void done(const Unit&) const {}
};

template <class Epi, class Sched, bool ALIGN_EPI = false, bool SP2 = false>
__device__ __forceinline__ void gemm_phase(PG8_LAS unsigned char* lds, const Gemm g, const Sched& S, const Epi& E) {
    const int tid = threadIdx.x, wid = __builtin_amdgcn_readfirstlane(tid >> 6), lane = tid & 63, wr = wid >> 2, wc = wid & 3, fr = lane & 15, fq = lane >> 4;
    const int K = g.K, nt = K / BK;
    unsigned voffA[2], voffB[2];
#pragma unroll
    for (int i = 0; i < 2; ++i) { int R, C; stage_rc(tid * 16 + i * 8192, R, C); const int Rb = Epi::PERM ? ((R & ~31) + perm32(R & 31)) : R;
        voffA[i] = (unsigned)(R * K + C) * 2u; voffB[i] = (unsigned)(Rb * K + C) * 2u; }
    const size_t kstep = (size_t)(BK * 2);
    const size_t hstep = (size_t)HALF * K * 2;
    const size_t tstep = 2 * hstep;
    const unsigned ldsw = (unsigned)wid * 1024u;
    const int aoff = lds_byte(wr * 64 + fr, fq * 8), boff = lds_byte(wc * 32 + fr, fq * 8);
#define PG8_SA(b, h) (((b) * 2 + (h)) * HTB)
#define PG8_SB(b, h) ((4 + (b) * 2 + (h)) * HTB)
#define PG8_STAGE(bufoff, gbase, voff) do { _Pragma("unroll") for (int _i = 0; _i < 2; ++_i) \
        __builtin_amdgcn_global_load_lds((const unsigned*)((const char*)(gbase) + (voff)[_i]), (PG8_LAS unsigned*)(lds + (bufoff) + ldsw + _i * 8192), 16, 0, 0); } while (0)
#define PG8_LDA(dst, b, h) do { _Pragma("unroll") for (int m = 0; m < 4; ++m) _Pragma("unroll") for (int k = 0; k < 2; ++k) dst[m][k] = *(const PG8_LAS bf16x8*)(lds + PG8_SA(b, h) + aoff + m * 2048 + k * 1024); } while (0)
#define PG8_LDB(dst, b, h) do { _Pragma("unroll") for (int n = 0; n < 2; ++n) _Pragma("unroll") for (int k = 0; k < 2; ++k) dst[n][k] = *(const PG8_LAS bf16x8*)(lds + PG8_SB(b, h) + boff + n * 2048 + k * 1024); } while (0)
#define PG8_MMA(ai, bj, At, Bt) do { __builtin_amdgcn_s_setprio(1); _Pragma("unroll") for (int m = 0; m < 4; ++m) _Pragma("unroll") for (int n = 0; n < 2; ++n) _Pragma("unroll") for (int k = 0; k < 2; ++k) \
        acc[ai][bj][m][n] = __builtin_amdgcn_mfma_f32_16x16x32_bf16(Bt[n][k], At[m][k], acc[ai][bj][m][n], 0, 0, 0); __builtin_amdgcn_s_setprio(0); } while (0)
#define PG8_WAIT_V(n) asm volatile("s_waitcnt vmcnt(" #n ")" ::: "memory")
#define PG8_WAIT_L(n) asm volatile("s_waitcnt lgkmcnt(" #n ")" ::: "memory")
#define PG8_BAR __builtin_amdgcn_s_barrier()
#define PG8_SCHED __builtin_amdgcn_sched_barrier(0)
    Unit cur, nxt; int ui = 0;
    if (!S.next(0, cur)) return;
    f32x4 acc[2][2][4][2];
#pragma unroll
    for (int a = 0; a < 2; ++a)
#pragma unroll
        for (int b = 0; b < 2; ++b)
#pragma unroll
            for (int m = 0; m < 4; ++m)
#pragma unroll
                for (int n = 0; n < 2; ++n) acc[a][b][m][n] = (f32x4){0.f, 0.f, 0.f, 0.f};
    bf16x8 At[4][2], B0[2][2], B1[2][2];
    const char* cA = (const char*)(cur.src ? g.A2 : g.A) + (size_t)cur.pm * tstep; const char* cB = (const char*)(cur.src ? g.Bt2 : g.Bt) + (size_t)cur.pn * tstep;
    S.a_ready(cur);
    if constexpr (SP2) {
        PG8_STAGE(PG8_SB(0, 0), cB, voffB); PG8_STAGE(PG8_SB(0, 1), cB + hstep, voffB); PG8_STAGE(PG8_SA(0, 0), cA, voffA); PG8_STAGE(PG8_SA(0, 1), cA + hstep, voffA);
        if (wr == 1) PG8_BAR;
        PG8_WAIT_V(2); PG8_BAR;
        PG8_STAGE(PG8_SB(1, 0), cB + kstep, voffB); PG8_STAGE(PG8_SA(1, 0), cA + kstep, voffA); PG8_STAGE(PG8_SB(1, 1), cB + hstep + kstep, voffB);
        PG8_WAIT_V(6); PG8_BAR;
    } else {
        PG8_STAGE(PG8_SB(0, 0), cB, voffB); PG8_STAGE(PG8_SA(0, 0), cA, voffA); PG8_STAGE(PG8_SB(0, 1), cB + hstep, voffB); PG8_STAGE(PG8_SA(0, 1), cA + hstep, voffA);
        if (wr == 1) PG8_BAR;
        PG8_WAIT_V(4); PG8_BAR;
        PG8_STAGE(PG8_SB(1, 0), cB + kstep, voffB); PG8_STAGE(PG8_SA(1, 0), cA + kstep, voffA); PG8_STAGE(PG8_SB(1, 1), cB + hstep + kstep, voffB);
        PG8_WAIT_V(6); PG8_BAR;
    }
    for (;;) {
        const bool has_next = S.next(ui + 1, nxt);
        const char* nA = has_next ? (const char*)(nxt.src ? g.A2 : g.A) + (size_t)nxt.pm * tstep : cA; const char* nB = has_next ? (const char*)(nxt.src ? g.Bt2 : g.Bt) + (size_t)nxt.pn * tstep : cB;
        for (int t = 0; t < nt; t += 2) {
            const bool last = (t == nt - 2);
            const char* a1 = cA + (size_t)(t + 1) * kstep;
            const char* a2 = last ? nA : cA + (size_t)(t + 2) * kstep; const char* b2 = last ? nB : cB + (size_t)(t + 2) * kstep;
            const char* a3 = a2 + kstep; const char* b3 = b2 + kstep;
            if (last && has_next) S.a_ready(nxt);
            if constexpr (SP2) {
            PG8_LDB(B0, 0, 0); PG8_LDB(B1, 0, 1); PG8_SCHED; PG8_LDA(At, 0, 0); PG8_STAGE(PG8_SA(1, 1), a1 + hstep, voffA);
            PG8_WAIT_V(8); PG8_WAIT_L(0); PG8_BAR; PG8_MMA(0, 0, At, B0); PG8_MMA(0, 1, At, B1); PG8_BAR; PG8_SCHED;
            PG8_LDA(At, 0, 1); PG8_STAGE(PG8_SB(0, 0), b2, voffB); PG8_STAGE(PG8_SB(0, 1), b2 + hstep, voffB); PG8_STAGE(PG8_SA(0, 0), a2, voffA);
            PG8_WAIT_V(8); PG8_WAIT_L(0); PG8_BAR; PG8_MMA(1, 0, At, B0); PG8_MMA(1, 1, At, B1); PG8_BAR; PG8_SCHED;
            PG8_LDB(B0, 1, 0); PG8_LDB(B1, 1, 1); PG8_SCHED; PG8_LDA(At, 1, 0); PG8_STAGE(PG8_SA(0, 1), a2 + hstep, voffA);
            PG8_WAIT_V(8); PG8_WAIT_L(0); PG8_BAR; PG8_MMA(0, 0, At, B0); PG8_MMA(0, 1, At, B1); PG8_BAR; PG8_SCHED;
            PG8_LDA(At, 1, 1); PG8_STAGE(PG8_SB(1, 0), b3, voffB); PG8_STAGE(PG8_SB(1, 1), b3 + hstep, voffB); PG8_STAGE(PG8_SA(1, 0), a3, voffA);
            PG8_WAIT_V(8); PG8_WAIT_L(0); PG8_BAR; PG8_MMA(1, 0, At, B0); PG8_MMA(1, 1, At, B1); PG8_BAR; PG8_SCHED;
            } else {
            PG8_LDB(B0, 0, 0); PG8_SCHED; PG8_LDA(At, 0, 0); PG8_STAGE(PG8_SA(1, 1), a1 + hstep, voffA);
            PG8_WAIT_L(8); PG8_BAR; PG8_WAIT_L(0); PG8_MMA(0, 0, At, B0); PG8_BAR; PG8_SCHED;
            PG8_LDB(B1, 0, 1); PG8_STAGE(PG8_SB(0, 0), b2, voffB);
            PG8_BAR; PG8_WAIT_L(0); PG8_MMA(0, 1, At, B1); PG8_BAR;
            PG8_LDA(At, 0, 1); PG8_STAGE(PG8_SA(0, 0), a2, voffA);
            PG8_BAR; PG8_WAIT_L(0); PG8_MMA(1, 0, At, B0); PG8_BAR; PG8_SCHED;
            PG8_STAGE(PG8_SB(0, 1), b2 + hstep, voffB);
            PG8_WAIT_V(6); PG8_BAR; PG8_MMA(1, 1, At, B1); PG8_BAR;
            PG8_LDB(B0, 1, 0); PG8_SCHED; PG8_LDA(At, 1, 0); PG8_STAGE(PG8_SA(0, 1), a2 + hstep, voffA);
            PG8_WAIT_L(8); PG8_BAR; PG8_WAIT_L(0); PG8_MMA(0, 0, At, B0); PG8_BAR; PG8_SCHED;
            PG8_LDB(B1, 1, 1); PG8_STAGE(PG8_SB(1, 0), b3, voffB);
            PG8_BAR; PG8_WAIT_L(0); PG8_MMA(0, 1, At, B1); PG8_BAR;
            PG8_LDA(At, 1, 1); PG8_STAGE(PG8_SA(1, 0), a3, voffA);
            PG8_BAR; PG8_WAIT_L(0); PG8_MMA(1, 0, At, B0); PG8_BAR; PG8_SCHED;
            PG8_STAGE(PG8_SB(1, 1), b3 + hstep, voffB);
            PG8_WAIT_V(6); PG8_BAR; PG8_MMA(1, 1, At, B1); PG8_BAR;
            }
        }
        if constexpr (ALIGN_EPI) { if (wr == 0) PG8_BAR; }
        if constexpr (!Epi::AFTER_DRAIN) { E(acc, cur, wr, wc, fr, fq); S.done(cur); }
        if (!has_next) break;
        if (!(Epi::CHAIN && cur.src == 0)) {
#pragma unroll
        for (int a = 0; a < 2; ++a)
#pragma unroll
            for (int b = 0; b < 2; ++b)
#pragma unroll
                for (int m = 0; m < 4; ++m)
#pragma unroll
                    for (int n = 0; n < 2; ++n) acc[a][b][m][n] = (f32x4){0.f, 0.f, 0.f, 0.f};
        }
        cur = nxt; cA = nA; cB = nB; ++ui;
        if constexpr (ALIGN_EPI) { if (wr == 1) PG8_BAR; }
    }
    PG8_WAIT_V(0);
    if constexpr (!ALIGN_EPI) { if (wr == 0) PG8_BAR; }
    PG8_BAR;
    if constexpr (Epi::AFTER_DRAIN) { E.fused(acc, cur, wr, wc, fr, fq, lds, wid, lane); S.done(cur); }
#undef PG8_SA
#undef PG8_SB
#undef PG8_STAGE
#undef PG8_LDA
#undef PG8_LDB
#undef PG8_MMA
#undef PG8_WAIT_V
#undef PG8_WAIT_L
#undef PG8_BAR
#undef PG8_SCHED
}
}

constexpr int NWAVES = 8;
constexpr int BATCH = 8, SEQ = 2048, D = 1024, M = BATCH * SEQ;
constexpr int NH = 24, HD = 64, AW = NH * HD  , AO = 512, PW = 512, DFF = 2816;
constexpr int NIN = PW + 3 * AW + 2 * D;
constexpr float RMS_EPS = 1e-6f;
#ifndef MK_N_LAUNCHES
#define MK_N_LAUNCHES 1
#endif
constexpr int NPH = 10;

constexpr size_t MiB = 1u << 20;
constexpr size_t WS_ROPE = 0;
constexpr size_t WS_CTL = 512 * 1024;
constexpr size_t WS_W1 = 1 * MiB;
constexpr size_t WS_WPB = 15 * MiB, WS_WAB = 16 * MiB;
constexpr size_t WS_WOUT = 17 * MiB;
constexpr size_t WS_WGU = 19 * MiB;
constexpr size_t WS_WDN = 30 * MiB;
constexpr size_t WS_H = 36 * MiB;
constexpr size_t WS_Z = 68 * MiB;
constexpr size_t WS_Q = 84 * MiB, WS_K = 132 * MiB, WS_V = 180 * MiB;
constexpr size_t WS_LSE = 228 * MiB;
constexpr size_t WS_END = 230 * MiB;

#define LAS __attribute__((address_space(3)))
typedef unsigned short bf16;
typedef unsigned v4u __attribute__((ext_vector_type(4)));
typedef unsigned v2u __attribute__((ext_vector_type(2)));
typedef float f32x4 __attribute__((ext_vector_type(4)));
typedef float f32x16 __attribute__((ext_vector_type(16)));
typedef short bf16x8 __attribute__((ext_vector_type(8)));
typedef short s16x4 __attribute__((ext_vector_type(4)));
using pg8::cvtpk; using pg8::pack8; using pg8::unpack8;

constexpr int RING_BYTES = 131072;
constexpr int LDS_BYTES = 147456;

__device__ __forceinline__ float wave_sum(float v) {
#pragma unroll
    for (int o = 1; o < 64; o <<= 1) v += __shfl_xor(v, o);
    return v;
}


#define RLX_AGENT __ATOMIC_RELAXED, __HIP_MEMORY_SCOPE_AGENT
#define XB_TMO      128
#define XB_XCNT(j)  (256  + 64 * (j))
#define XB_XSUB(j)  (1280 + 64 * (j))
#define XB_XGEN(j)  (2304 + 64 * (j))
#define XB_TOP      3328
#define XB_TOPGEN   3392
#define XCD_BAR_WORDS 3456
#define XB_SPIN_CAP (1u << 18)

__device__ __forceinline__ unsigned xb_ld(unsigned* p)              { return __hip_atomic_load(p, __ATOMIC_RELAXED, __HIP_MEMORY_SCOPE_AGENT); }
__device__ __forceinline__ unsigned xb_add(unsigned* p, unsigned v) { return __hip_atomic_fetch_add(p, v, __ATOMIC_RELAXED, __HIP_MEMORY_SCOPE_AGENT); }
__device__ __forceinline__ unsigned xb_xcc_id() { return (unsigned)__builtin_amdgcn_s_getreg((3 << 11) | 20) & 0xFu; }
#define XB_SPIN(cond, bar) do { unsigned _sp = 0; while (cond) { __builtin_amdgcn_s_sleep(1); \
    if ((++_sp & 255u) == 0u) { if (xb_ld(&(bar)[XB_TMO])) break; if (_sp > XB_SPIN_CAP) { atomicAdd(&(bar)[XB_TMO], 1u); break; } } } } while (0)

struct XcdBarrier {
    unsigned* bar; unsigned x;
    volatile LAS unsigned* st;
};

__device__ __forceinline__ XcdBarrier xcd_barrier_post(unsigned* bar, volatile LAS unsigned* st) {
    XcdBarrier b; b.bar = bar; b.x = xb_xcc_id(); b.st = st;
    if (threadIdx.x == 0) (void)xb_add(&bar[XB_XCNT(b.x)], 1u);
    return b;
}
__device__ __forceinline__ void xcd_barrier_complete(unsigned* bar, unsigned x, unsigned& nloc, unsigned& nx) {
    const unsigned G = gridDim.x * gridDim.y * gridDim.z;
    unsigned sum, cnt, mine, sp = 0u;
    for (;;) {
        sum = 0u; cnt = 0u; mine = 0u;
#pragma unroll
        for (unsigned j = 0; j < 16; ++j) { const unsigned c = xb_ld(&bar[XB_XCNT(j)]); sum += c; cnt += (c > 0u) ? 1u : 0u; mine = (j == x) ? c : mine; }
        if (sum == G) break;
        __builtin_amdgcn_s_sleep(1);
        if ((++sp & 255u) == 0u) { if (xb_ld(&bar[XB_TMO])) break; if (sp > XB_SPIN_CAP) { atomicAdd(&bar[XB_TMO], 1u); break; } }
    }
    nloc = mine > 0u ? mine : 1u; nx = cnt > 0u ? cnt : 1u;
}

__device__ __forceinline__ void xcd_barrier(const XcdBarrier& b) {
    asm volatile("s_waitcnt vmcnt(0)" ::: "memory");
    __syncthreads();
    if (threadIdx.x == 0) {
        unsigned* bar = b.bar;
        __builtin_amdgcn_s_waitcnt(0);
        unsigned nloc = b.st[0], nx = b.st[1];
        if (nloc == 0u) { xcd_barrier_complete(bar, b.x, nloc, nx); b.st[0] = nloc; b.st[1] = nx; }
        const unsigned old = xb_add(&bar[XB_XSUB(b.x)], 1u);
        const unsigned gen = old / nloc;
        if (old + 1u == (gen + 1u) * nloc) {
            __builtin_amdgcn_fence(__ATOMIC_RELEASE, "agent");
            asm volatile("s_waitcnt vmcnt(0)" ::: "memory");
            const unsigned og = xb_add(&bar[XB_TOP], 1u);
            const unsigned tg = og / nx;
            if (og + 1u == (tg + 1u) * nx) xb_add(&bar[XB_TOPGEN], 1u);
            else XB_SPIN(xb_ld(&bar[XB_TOPGEN]) == tg, bar);
            __builtin_amdgcn_fence(__ATOMIC_ACQUIRE, "agent");
            xb_add(&bar[XB_XGEN(b.x)], 1u);
            asm volatile("s_waitcnt vmcnt(0)" ::: "memory");
        } else {
            XB_SPIN(xb_ld(&bar[XB_XGEN(b.x)]) == gen, bar);
            __builtin_amdgcn_fence(__ATOMIC_ACQUIRE, "agent");
            asm volatile("s_waitcnt vmcnt(0)" ::: "memory");
        }
    }
    __syncthreads();
}

__device__ __forceinline__ void p0_transpose_item(const float* W, int K, int N, bf16* WT, int k0, int n0, int drow0, LAS float* scr, int lane) {
    f32x4 v[8];
#pragma unroll
    for (int i = 0; i < 8; ++i) v[i] = *(const f32x4*)(W + (size_t)(k0 + 8 * i + (lane >> 3)) * N + n0 + 4 * (lane & 7));
#pragma unroll
    for (int i = 0; i < 8; ++i) { LAS float* d = scr + (8 * i + (lane >> 3)) * 33 + 4 * (lane & 7); d[0] = v[i][0]; d[1] = v[i][1]; d[2] = v[i][2]; d[3] = v[i][3]; }
    asm volatile("s_waitcnt lgkmcnt(0)" ::: "memory");
    const int c = lane & 7;
#pragma unroll
    for (int j = 0; j < 4; ++j) { const int n = (lane >> 3) + 8 * j; const LAS float* s = scr + (8 * c) * 33 + n;
        v4u o; o.x = cvtpk(s[0 * 33], s[1 * 33]); o.y = cvtpk(s[2 * 33], s[3 * 33]); o.z = cvtpk(s[4 * 33], s[5 * 33]); o.w = cvtpk(s[6 * 33], s[7 * 33]);
        *(v4u*)(WT + (size_t)(drow0 + n) * K + k0 + 8 * c) = o; }
    asm volatile("s_waitcnt lgkmcnt(0)" ::: "memory");
}
__device__ __forceinline__ void sincos_d(double a, double& s, double& c) {
    const double kd = __builtin_rint(a * 0.63661977236758134308);
    double r = __builtin_fma(-kd, 1.57079632679489655800e+00, a); r = __builtin_fma(-kd, 6.12323399573676603587e-17, r);
    const double r2 = r * r;
    double sp = -1.0 / 1307674368000.0; sp = sp * r2 + 1.0 / 6227020800.0; sp = sp * r2 - 1.0 / 39916800.0; sp = sp * r2 + 1.0 / 362880.0; sp = sp * r2 - 1.0 / 5040.0; sp = sp * r2 + 1.0 / 120.0; sp = sp * r2 - 1.0 / 6.0; sp = sp * r2 + 1.0; sp *= r;
    double cp = 1.0 / 20922789888000.0; cp = cp * r2 - 1.0 / 87178291200.0; cp = cp * r2 + 1.0 / 479001600.0; cp = cp * r2 - 1.0 / 3628800.0; cp = cp * r2 + 1.0 / 40320.0; cp = cp * r2 - 1.0 / 720.0; cp = cp * r2 + 1.0 / 24.0; cp = cp * r2 - 0.5; cp = cp * r2 + 1.0;
    const int k = (int)kd & 3;
    s = (k == 0) ? sp : (k == 1) ? cp : (k == 2) ? -sp : -cp;
    c = (k == 0) ? cp : (k == 1) ? -sp : (k == 2) ? -cp : sp;
}
__device__ __forceinline__ void rms_rows_to_bf16(const float* x, const float* g, bf16* out, int lane, int gw, int NGW) {
    const f32x4 g0 = *(const f32x4*)(g + 8 * lane), g1 = *(const f32x4*)(g + 8 * lane + 4), g2 = *(const f32x4*)(g + 512 + 8 * lane), g3 = *(const f32x4*)(g + 512 + 8 * lane + 4);
    for (int base = gw; base < M; base += 4 * NGW) {
        f32x4 v[4][4]; int rowk[4];
#pragma unroll
        for (int k = 0; k < 4; ++k) { rowk[k] = base + k * NGW; const int rr = rowk[k] < M ? rowk[k] : M - 1; const float* xr = x + (size_t)rr * D;
            v[k][0] = *(const f32x4*)(xr + 8 * lane); v[k][1] = *(const f32x4*)(xr + 8 * lane + 4); v[k][2] = *(const f32x4*)(xr + 512 + 8 * lane); v[k][3] = *(const f32x4*)(xr + 512 + 8 * lane + 4); }
        float ss[4];
#pragma unroll
        for (int k = 0; k < 4; ++k) { float a = 0.f;
#pragma unroll
            for (int j = 0; j < 4; ++j) a += (v[k][j][0] * v[k][j][0] + v[k][j][1] * v[k][j][1]) + (v[k][j][2] * v[k][j][2] + v[k][j][3] * v[k][j][3]);
            ss[k] = a; }
#pragma unroll
        for (int o = 1; o < 64; o <<= 1) {
#pragma unroll
            for (int k = 0; k < 4; ++k) ss[k] += __shfl_xor(ss[k], o); }
#pragma unroll
        for (int k = 0; k < 4; ++k) if (rowk[k] < M) { const float rs = 1.0f / sqrtf(ss[k] * (1.0f / D) + RMS_EPS); bf16* orow = out + (size_t)rowk[k] * D;
            *(v4u*)(orow + 8 * lane) = pack8(v[k][0] * rs * g0, v[k][1] * rs * g1);
            *(v4u*)(orow + 512 + 8 * lane) = pack8(v[k][2] * rs * g2, v[k][3] * rs * g3); }
    }
}

struct Args { const float* in[14]; float* out; unsigned char* ws; int ph_lo, ph_hi; };

__device__ __forceinline__ void p0_prologue(const Args& A, LAS unsigned char* lds, int wave, int lane, int gw, int NGW) {
    unsigned char* ws = A.ws;
    const float *x = A.in[0], *g_pre = A.in[1], *w_in = A.in[2], *w_grp = A.in[3], *pscale = A.in[4], *w_pbr = A.in[5], *w_abr = A.in[6], *w_out = A.in[7],
                *w_g = A.in[10], *w_u = A.in[11], *w_d = A.in[12];
    bf16 *W1 = (bf16*)(ws + WS_W1), *WPB = (bf16*)(ws + WS_WPB), *WAB = (bf16*)(ws + WS_WAB), *WOUT = (bf16*)(ws + WS_WOUT), *WGU = (bf16*)(ws + WS_WGU), *WDN = (bf16*)(ws + WS_WDN);
    LAS float* scr = (LAS float*)(lds + wave * 16384);
    constexpr int I_IN = 16 * 208, I_BR = 8 * 32, I_OUT = 16 * 32, I_GU = 16 * 88, I_DN = 44 * 32;
    constexpr int NT = I_IN + 2 * I_BR + I_OUT + 2 * I_GU + I_DN;
    for (int it = gw; it < NT; it += NGW) {
        int r = it;
        if (r < I_IN) { const int kb = r / 208, nb = 16 + r % 208, c = 32 * nb; int dr = c;
            if (c < 3584) { const int tb = c & ~255, g32 = (c & 255) >> 5; dr = tb + (g32 & 1) * 128 + (g32 >> 1) * 32; }
            p0_transpose_item(w_in, D, NIN, W1, 64 * kb, c, dr, scr, lane); continue; } r -= I_IN;
        if (r < I_BR) { p0_transpose_item(w_pbr, PW, D, WPB, 64 * (r / 32), 32 * (r % 32), 32 * (r % 32), scr, lane); continue; } r -= I_BR;
        if (r < I_BR) { p0_transpose_item(w_abr, AO, D, WAB, 64 * (r / 32), 32 * (r % 32), 32 * (r % 32), scr, lane); continue; } r -= I_BR;
        if (r < I_OUT) { p0_transpose_item(w_out, D, D, WOUT, 64 * (r / 32), 32 * (r % 32), 32 * (r % 32), scr, lane); continue; } r -= I_OUT;
        if (r < I_GU) { const int c = 32 * (r % 88); p0_transpose_item(w_g, D, DFF, WGU, 64 * (r / 88), c, 256 * (c >> 7) + (c & 127), scr, lane); continue; } r -= I_GU;
        if (r < I_GU) { const int c = 32 * (r % 88); p0_transpose_item(w_u, D, DFF, WGU, 64 * (r / 88), c, 256 * (c >> 7) + 128 + (c & 127), scr, lane); continue; } r -= I_GU;
        p0_transpose_item(w_d, DFF, D, WDN, 64 * (r / 32), 32 * (r % 32), 32 * (r % 32), scr, lane);
    }
    for (int it = gw; it < 512; it += NGW) {
        const int g = it >> 7, kb = (it >> 1) & 63, jh = it & 1, k0 = 16 * kb, j = jh * 64 + lane;
#pragma unroll
        for (int i = 0; i < 16; ++i) { const float* src = w_in + (size_t)(k0 + i) * NIN + g * 128 + 2 * lane; scr[i * 128 + 2 * lane] = src[0]; scr[i * 128 + 2 * lane + 1] = src[1]; }
        asm volatile("s_waitcnt lgkmcnt(0)" ::: "memory");
        float acc[16];
#pragma unroll
        for (int i = 0; i < 16; ++i) acc[i] = 0.f;
        const float* wg = w_grp + (size_t)g * 128 * 128 + j;
        for (int c = 0; c < 128; c += 4) {
            const float w0 = wg[(c + 0) * 128], w1 = wg[(c + 1) * 128], w2 = wg[(c + 2) * 128], w3 = wg[(c + 3) * 128];
#pragma unroll
            for (int i = 0; i < 16; ++i) { const f32x4 a = *(const LAS f32x4*)(scr + i * 128 + c); acc[i] += a[0] * w0 + a[1] * w1 + a[2] * w2 + a[3] * w3; }
        }
        const float sc = pscale[g * 128 + j];
        bf16* dst = W1 + (size_t)(g * 128 + j) * D + k0;
        v4u o0, o1;
        o0.x = cvtpk(acc[0] * sc, acc[1] * sc); o0.y = cvtpk(acc[2] * sc, acc[3] * sc); o0.z = cvtpk(acc[4] * sc, acc[5] * sc); o0.w = cvtpk(acc[6] * sc, acc[7] * sc);
        o1.x = cvtpk(acc[8] * sc, acc[9] * sc); o1.y = cvtpk(acc[10] * sc, acc[11] * sc); o1.z = cvtpk(acc[12] * sc, acc[13] * sc); o1.w = cvtpk(acc[14] * sc, acc[15] * sc);
        *(v4u*)dst = o0; *(v4u*)(dst + 8) = o1;
        asm volatile("s_waitcnt lgkmcnt(0)" ::: "memory");
    }
    float* rope = (float*)(ws + WS_ROPE);
    for (int e = gw * 64 + lane; e < 2048 * 32; e += NGW * 64) {
        const int pos = e >> 5, f = e & 31;
        const float inv = (float)exp2(-(double)f * (13.287712379549449 / 32.0));
        const float ang = (float)pos * inv;
        double s, c; sincos_d((double)ang, s, c);
        rope[pos * 64 + f] = (float)c; rope[pos * 64 + 32 + f] = (float)s;
    }
    bf16* H = (bf16*)(ws + WS_H);
    rms_rows_to_bf16(x, g_pre, H, lane, gw, NGW);
}

__device__ __forceinline__ int crow(int r, int hi) { return (r & 3) + 8 * (r >> 2) + 4 * hi; }
__device__ __forceinline__ void att_decode(int u, int& b, int& h, int& dsh, int& r, int& qb) {
    const int qbg = u & 63; h = (u >> 6) % NH; b = u / (64 * NH); dsh = (h >> 3) * 2; r = qbg >> (6 - dsh); qb = qbg & ((64 >> dsh) - 1);
}
__device__ __forceinline__ void att_load_kq(int u, const bf16* Q, const bf16* K, int q, int hi, bf16x8 (&kf)[5][4], bf16x8 (&qf)[4]) {
    int b, h, dsh, r, qb; att_decode(u, b, h, dsh, r, qb);
    const int L = SEQ >> dsh;
    const bf16* qp = Q + ((size_t)b * SEQ + ((size_t)(32 * qb + q) << dsh) + r) * AW + h * 64 + hi * 32;
#pragma unroll
    for (int d0 = 0; d0 < 4; ++d0) qf[d0] = *(const bf16x8*)(qp + d0 * 8);
#pragma unroll
    for (int T = 0; T < 5; ++T) { int lk = 32 * qb - 64 + 32 * T + q; lk = lk < 0 ? 0 : (lk > L - 1 ? L - 1 : lk);
        const bf16* kp = K + ((size_t)b * SEQ + ((size_t)lk << dsh) + r) * AW + h * 64 + hi * 32;
#pragma unroll
        for (int d0 = 0; d0 < 4; ++d0) kf[T][d0] = *(const bf16x8*)(kp + d0 * 8); }
}
__device__ __forceinline__ v4u att_load_v(const bf16* V, int b, int h, int dsh, int r, int qb, int L, int T, int pc, int lane) {
    int lk = 32 * qb - 64 + 32 * T + 8 * pc + (lane >> 3); lk = lk < 0 ? 0 : (lk > L - 1 ? L - 1 : lk);
    return *(const v4u*)(V + ((size_t)b * SEQ + ((size_t)lk << dsh) + r) * AW + h * 64 + (lane & 7) * 8);
}
__device__ __forceinline__ s16x4 vtr(const LAS unsigned char* p) { typedef short v4i16_t __attribute__((ext_vector_type(4))); return __builtin_bit_cast(s16x4, __builtin_amdgcn_ds_read_tr16_b64_v4i16((LAS v4i16_t*)p)); }

__device__ __forceinline__ void attn_phase(LAS unsigned char* lds, bf16* QO, const bf16* Kb, const bf16* Vb, float* LSE, int wave, int lane, int gw, int NGW) {
    constexpr int NU = BATCH * NH * 64;
    const int q = lane & 31, hi = lane >> 5;
    LAS unsigned char* vl = lds + wave * 16384;
    const int vw0 = (lane >> 3) * 128 + (((lane & 7) * 16) ^ (((lane >> 4) & 1) << 6));
    const int q4 = (lane & 15) >> 2, p4 = lane & 3, gsel = (lane >> 4) & 1, bsw = (q4 >> 1) & 1;
    const int tr0 = (4 * hi + q4) * 128 + ((0 ^ bsw) << 6) + 32 * gsel + 8 * p4;
    const int tr1 = (4 * hi + q4) * 128 + ((1 ^ bsw) << 6) + 32 * gsel + 8 * p4;
    bf16x8 kf[5][4], qf[4];
    int u = gw;
#ifdef ATT_PREFETCH
    if (u < NU) att_load_kq(u, QO, Kb, q, hi, kf, qf);
#endif
    for (; u < NU; u += NGW) {
        int b, h, dsh, r, qb; att_decode(u, b, h, dsh, r, qb);
#ifndef ATT_PREFETCH
        att_load_kq(u, QO, Kb, q, hi, kf, qf);
#endif
        const int L = SEQ >> dsh;
        f32x16 s[5];
#pragma unroll
        for (int T = 0; T < 5; ++T) { s[T] = (f32x16){0.f, 0.f, 0.f, 0.f, 0.f, 0.f, 0.f, 0.f, 0.f, 0.f, 0.f, 0.f, 0.f, 0.f, 0.f, 0.f};
#pragma unroll
            for (int d0 = 0; d0 < 4; ++d0) s[T] = __builtin_amdgcn_mfma_f32_32x32x16_bf16(kf[T][d0], qf[d0], s[T], 0, 0, 0); }
        __builtin_amdgcn_sched_barrier(0);
        v4u vr[3][4];
#pragma unroll
        for (int T = 0; T < 3; ++T)
#pragma unroll
            for (int pc = 0; pc < 4; ++pc) vr[T][pc] = att_load_v(Vb, b, h, dsh, r, qb, L, T, pc, lane);
        __builtin_amdgcn_sched_barrier(0);
        float mx = -INFINITY;
#pragma unroll
        for (int T = 0; T < 5; ++T)
#pragma unroll
            for (int i = 0; i < 16; ++i) { const int kk = crow(i, hi), rel = 32 * T + kk - 64 - q, lk = 32 * qb - 64 + 32 * T + kk;
                const bool ok = (rel >= -64) && (rel <= 64) && (lk >= 0) && (lk < L);
                s[T][i] = ok ? s[T][i] : -INFINITY; mx = fmaxf(mx, s[T][i]); }
        mx = fmaxf(mx, __shfl_xor(mx, 32));
        float sum = 0.f;
#pragma unroll
        for (int T = 0; T < 5; ++T)
#pragma unroll
            for (int i = 0; i < 16; ++i) { const float p = __builtin_amdgcn_exp2f(s[T][i] - mx); s[T][i] = p; sum += p; }
        sum += __shfl_xor(sum, 32);
        bf16x8 pw[5][2];
#pragma unroll
        for (int T = 0; T < 5; ++T)
#pragma unroll
            for (int s2 = 0; s2 < 2; ++s2) { v4u w; w.x = cvtpk(s[T][8 * s2 + 0], s[T][8 * s2 + 1]); w.y = cvtpk(s[T][8 * s2 + 2], s[T][8 * s2 + 3]); w.z = cvtpk(s[T][8 * s2 + 4], s[T][8 * s2 + 5]); w.w = cvtpk(s[T][8 * s2 + 6], s[T][8 * s2 + 7]);
                pw[T][s2] = __builtin_bit_cast(bf16x8, w); }
        asm volatile("" ::: "memory"); __builtin_amdgcn_sched_barrier(0);
#pragma unroll
        for (int T = 0; T < 3; ++T)
#pragma unroll
            for (int pc = 0; pc < 4; ++pc) *(LAS v4u*)(vl + T * 4096 + pc * 1024 + vw0) = vr[T][pc];
        v4u vr2[2][4];
#pragma unroll
        for (int T = 0; T < 2; ++T)
#pragma unroll
            for (int pc = 0; pc < 4; ++pc) vr2[T][pc] = att_load_v(Vb, b, h, dsh, r, qb, L, 3 + T, pc, lane);
        asm volatile("" ::: "memory");
        f32x16 o[2];
        o[0] = (f32x16){0.f, 0.f, 0.f, 0.f, 0.f, 0.f, 0.f, 0.f, 0.f, 0.f, 0.f, 0.f, 0.f, 0.f, 0.f, 0.f}; o[1] = o[0];
#define ATT_PV(T, slot) do { _Pragma("unroll") for (int s2 = 0; s2 < 2; ++s2) { \
            const LAS unsigned char* b0_ = vl + (slot) * 4096 + s2 * 2048; \
            const s16x4 a00 = vtr(b0_ + tr0), a01 = vtr(b0_ + 1024 + tr0), a10 = vtr(b0_ + tr1), a11 = vtr(b0_ + 1024 + tr1); \
            const bf16x8 v0_ = (bf16x8){a00[0], a00[1], a00[2], a00[3], a01[0], a01[1], a01[2], a01[3]}; \
            const bf16x8 v1_ = (bf16x8){a10[0], a10[1], a10[2], a10[3], a11[0], a11[1], a11[2], a11[3]}; \
            o[0] = __builtin_amdgcn_mfma_f32_32x32x16_bf16(v0_, pw[T][s2], o[0], 0, 0, 0); \
            o[1] = __builtin_amdgcn_mfma_f32_32x32x16_bf16(v1_, pw[T][s2], o[1], 0, 0, 0); } } while (0)
        __builtin_amdgcn_sched_barrier(0);
        ATT_PV(0, 0); ATT_PV(1, 1); ATT_PV(2, 2);
        asm volatile("" ::: "memory"); __builtin_amdgcn_sched_barrier(0);
#pragma unroll
        for (int T = 0; T < 2; ++T)
#pragma unroll
            for (int pc = 0; pc < 4; ++pc) *(LAS v4u*)(vl + T * 4096 + pc * 1024 + vw0) = vr2[T][pc];
        asm volatile("" ::: "memory");
        __builtin_amdgcn_sched_barrier(0);
#ifdef ATT_PREFETCH
        const int un = u + NGW;
        if (un < NU) att_load_kq(un, QO, Kb, q, hi, kf, qf);
#endif
        __builtin_amdgcn_sched_barrier(0);
        ATT_PV(3, 0); ATT_PV(4, 1);
        asm volatile("" ::: "memory"); __builtin_amdgcn_sched_barrier(0);
#undef ATT_PV
        const float rl = 1.0f / sum;
        const size_t row = (size_t)b * SEQ + ((size_t)(32 * qb + q) << dsh) + r;
        bf16* op = QO + row * AW + h * 64 + 4 * hi;
#pragma unroll
        for (int dh = 0; dh < 2; ++dh)
#pragma unroll
            for (int rg = 0; rg < 4; ++rg) { v2u w; w.x = cvtpk(o[dh][4 * rg + 0] * rl, o[dh][4 * rg + 1] * rl); w.y = cvtpk(o[dh][4 * rg + 2] * rl, o[dh][4 * rg + 3] * rl);
                *(v2u*)(op + 32 * dh + 8 * rg) = w; }
        if (hi == 0) LSE[row * NH + h] = (mx + __builtin_log2f(sum)) * 0.6931471805599453f;
    }
}

__device__ __forceinline__ void merge_pool_phase(const bf16* O3, const float* LSE, const bf16* Z, bf16* PM, bf16* OATT, int lane, int gw, int NGW) {
    for (int ch = gw; ch < M / 8; ch += NGW) {
        const int row0 = ch * 8, t0 = row0 & (SEQ - 1);
        v4u zw[24];
#pragma unroll
        for (int j = 0; j < 24; ++j) { int tt = t0 - 8 + j; tt = tt < 0 ? 0 : (tt > SEQ - 1 ? SEQ - 1 : tt); zw[j] = *(const v4u*)(Z + (size_t)(row0 - t0 + tt) * PW + 8 * lane); }
        const int hs = lane >> 3, dc = (lane & 7) * 8;
#pragma unroll
        for (int hb = 0; hb < 2; ++hb) {
            float l[4][3]; v4u ow[4][3];
#pragma unroll
            for (int k = 0; k < 4; ++k) { const size_t row = row0 + 4 * hb + k;
#pragma unroll
                for (int g = 0; g < 3; ++g) { l[k][g] = LSE[row * NH + 8 * g + hs]; ow[k][g] = *(const v4u*)(O3 + row * AW + 512 * g + hs * 64 + dc); } }
#pragma unroll
            for (int k = 0; k < 4; ++k) { const size_t row = row0 + 4 * hb + k;
                const float mx = fmaxf(l[k][0], fmaxf(l[k][1], l[k][2]));
                float e0 = __expf(l[k][0] - mx), e1 = __expf(l[k][1] - mx), e2 = __expf(l[k][2] - mx);
                const float inv = 1.0f / (e0 + e1 + e2); e0 *= inv; e1 *= inv; e2 *= inv;
                f32x4 a0, a1, b0, b1, c0, c1;
                unpack8(ow[k][0], a0, a1); unpack8(ow[k][1], b0, b1); unpack8(ow[k][2], c0, c1);
                *(v4u*)(OATT + row * AO + hs * 64 + dc) = pack8(a0 * e0 + b0 * e1 + c0 * e2, a1 * e0 + b1 * e1 + c1 * e2); }
        }
        const int grp = lane >> 4, rad = 1 << grp;
#pragma unroll
        for (int i = 0; i < 8; ++i) {
            const int t = t0 + i; f32x4 s0, s1, c0, c1, sel0, sel1;
            unpack8(zw[i + 8], c0, c1); s0 = c0; s1 = c1;
#pragma unroll
            for (int off = 1; off <= 8; ++off) {
                f32x4 a0, a1;
                if (t - off >= 0) { unpack8(zw[i + 8 - off], a0, a1); s0 += a0; s1 += a1; }
                if (t + off < SEQ) { unpack8(zw[i + 8 + off], a0, a1); s0 += a0; s1 += a1; }
                if (off == 1) { sel0 = s0; sel1 = s1; }
                if (off == 2 || off == 4 || off == 8) { const bool take = rad >= off;
#pragma unroll
                    for (int e = 0; e < 4; ++e) { sel0[e] = take ? s0[e] : sel0[e]; sel1[e] = take ? s1[e] : sel1[e]; } }
            }
            int lo = t - rad; lo = lo < 0 ? 0 : lo; int hi_ = t + rad + 1; hi_ = hi_ > SEQ ? SEQ : hi_;
            const float ic = 1.0f / (float)(hi_ - lo);
            *(v4u*)(PM + (size_t)(row0 + i) * PW + 8 * lane) = pack8(sel0 * ic - c0, sel1 * ic - c1);
        }
    }
}

__device__ __forceinline__ void rows_mid(const float* x, const bf16* MIX, const float* gpost, const float* gpre2, float* X1, bf16* H2, int lane, int gw, int NGW) {
    for (int base = gw; base < M; base += 4 * NGW) {
        v4u mw[4][2]; f32x4 xv[4][4]; int rowk[4];
#pragma unroll
        for (int k = 0; k < 4; ++k) { rowk[k] = base + k * NGW; const int rr = rowk[k] < M ? rowk[k] : M - 1; const bf16* mp = MIX + (size_t)rr * D; const float* xp = x + (size_t)rr * D;
            mw[k][0] = *(const v4u*)(mp + 8 * lane); mw[k][1] = *(const v4u*)(mp + 512 + 8 * lane);
            xv[k][0] = *(const f32x4*)(xp + 8 * lane); xv[k][1] = *(const f32x4*)(xp + 8 * lane + 4); xv[k][2] = *(const f32x4*)(xp + 512 + 8 * lane); xv[k][3] = *(const f32x4*)(xp + 512 + 8 * lane + 4); }
        float ss[4];
#pragma unroll
        for (int k = 0; k < 4; ++k) { f32x4 mv[4]; unpack8(mw[k][0], mv[0], mv[1]); unpack8(mw[k][1], mv[2], mv[3]); float a = 0.f;
#pragma unroll
            for (int j = 0; j < 4; ++j) a += (mv[j][0] * mv[j][0] + mv[j][1] * mv[j][1]) + (mv[j][2] * mv[j][2] + mv[j][3] * mv[j][3]);
            ss[k] = a; }
#pragma unroll
        for (int o = 1; o < 64; o <<= 1) {
#pragma unroll
            for (int k = 0; k < 4; ++k) ss[k] += __shfl_xor(ss[k], o); }
        const f32x4 gp0 = *(const f32x4*)(gpost + 8 * lane), gp1 = *(const f32x4*)(gpost + 8 * lane + 4), gp2 = *(const f32x4*)(gpost + 512 + 8 * lane), gp3 = *(const f32x4*)(gpost + 512 + 8 * lane + 4);
        float s2[4];
#pragma unroll
        for (int k = 0; k < 4; ++k) { const float rs = 1.0f / sqrtf(ss[k] * (1.0f / D) + RMS_EPS); f32x4 mv[4]; unpack8(mw[k][0], mv[0], mv[1]); unpack8(mw[k][1], mv[2], mv[3]);
            xv[k][0] += mv[0] * rs * gp0; xv[k][1] += mv[1] * rs * gp1; xv[k][2] += mv[2] * rs * gp2; xv[k][3] += mv[3] * rs * gp3;
            if (rowk[k] < M) { float* x1p = X1 + (size_t)rowk[k] * D;
                *(f32x4*)(x1p + 8 * lane) = xv[k][0]; *(f32x4*)(x1p + 8 * lane + 4) = xv[k][1]; *(f32x4*)(x1p + 512 + 8 * lane) = xv[k][2]; *(f32x4*)(x1p + 512 + 8 * lane + 4) = xv[k][3]; }
            float a = 0.f;
#pragma unroll
            for (int j = 0; j < 4; ++j) a += (xv[k][j][0] * xv[k][j][0] + xv[k][j][1] * xv[k][j][1]) + (xv[k][j][2] * xv[k][j][2] + xv[k][j][3] * xv[k][j][3]);
            s2[k] = a; }
#pragma unroll
        for (int o = 1; o < 64; o <<= 1) {
#pragma unroll
            for (int k = 0; k < 4; ++k) s2[k] += __shfl_xor(s2[k], o); }
        const f32x4 g0 = *(const f32x4*)(gpre2 + 8 * lane), g1 = *(const f32x4*)(gpre2 + 8 * lane + 4), g2 = *(const f32x4*)(gpre2 + 512 + 8 * lane), g3 = *(const f32x4*)(gpre2 + 512 + 8 * lane + 4);
#pragma unroll
        for (int k = 0; k < 4; ++k) if (rowk[k] < M) { const float rs2 = 1.0f / sqrtf(s2[k] * (1.0f / D) + RMS_EPS); bf16* hp = H2 + (size_t)rowk[k] * D;
            *(v4u*)(hp + 8 * lane) = pack8(xv[k][0] * rs2 * g0, xv[k][1] * rs2 * g1);
            *(v4u*)(hp + 512 + 8 * lane) = pack8(xv[k][2] * rs2 * g2, xv[k][3] * rs2 * g3); }
    }
}
__device__ __forceinline__ void rows_final(const bf16* Fb, const float* gpost2, float* X1, int lane, int gw, int NGW) {
    const f32x4 g0 = *(const f32x4*)(gpost2 + 8 * lane), g1 = *(const f32x4*)(gpost2 + 8 * lane + 4), g2 = *(const f32x4*)(gpost2 + 512 + 8 * lane), g3 = *(const f32x4*)(gpost2 + 512 + 8 * lane + 4);
    for (int base = gw; base < M; base += 4 * NGW) {
        v4u fw[4][2]; f32x4 xv[4][4]; int rowk[4];
#pragma unroll
        for (int k = 0; k < 4; ++k) { rowk[k] = base + k * NGW; const int rr = rowk[k] < M ? rowk[k] : M - 1; const bf16* fp = Fb + (size_t)rr * D; const float* xp = X1 + (size_t)rr * D;
            fw[k][0] = *(const v4u*)(fp + 8 * lane); fw[k][1] = *(const v4u*)(fp + 512 + 8 * lane);
            xv[k][0] = *(const f32x4*)(xp + 8 * lane); xv[k][1] = *(const f32x4*)(xp + 8 * lane + 4); xv[k][2] = *(const f32x4*)(xp + 512 + 8 * lane); xv[k][3] = *(const f32x4*)(xp + 512 + 8 * lane + 4); }
        float ss[4];
#pragma unroll
        for (int k = 0; k < 4; ++k) { f32x4 fv[4]; unpack8(fw[k][0], fv[0], fv[1]); unpack8(fw[k][1], fv[2], fv[3]); float a = 0.f;
#pragma unroll
            for (int j = 0; j < 4; ++j) a += (fv[j][0] * fv[j][0] + fv[j][1] * fv[j][1]) + (fv[j][2] * fv[j][2] + fv[j][3] * fv[j][3]);
            ss[k] = a; }
#pragma unroll
        for (int o = 1; o < 64; o <<= 1) {
#pragma unroll
            for (int k = 0; k < 4; ++k) ss[k] += __shfl_xor(ss[k], o); }
#pragma unroll
        for (int k = 0; k < 4; ++k) if (rowk[k] < M) { const float rs = 1.0f / sqrtf(ss[k] * (1.0f / D) + RMS_EPS); f32x4 fv[4]; unpack8(fw[k][0], fv[0], fv[1]); unpack8(fw[k][1], fv[2], fv[3]);
            float* x1p = X1 + (size_t)rowk[k] * D;
            *(f32x4*)(x1p + 8 * lane) = xv[k][0] + fv[0] * rs * g0; *(f32x4*)(x1p + 8 * lane + 4) = xv[k][1] + fv[1] * rs * g1;
            *(f32x4*)(x1p + 512 + 8 * lane) = xv[k][2] + fv[2] * rs * g2; *(f32x4*)(x1p + 512 + 8 * lane + 4) = xv[k][3] + fv[3] * rs * g3; }
    }
}

__global__ void __launch_bounds__(NWAVES * 64, 2) fwd_megakernel(Args args) {
    extern __shared__ __attribute__((aligned(16))) unsigned char lds_raw[];
    LAS unsigned char* lds = (LAS unsigned char*)lds_raw;
    const int tid = threadIdx.x, lane = tid & 63, wave = __builtin_amdgcn_readfirstlane(tid >> 6);
    const int G = gridDim.x, gw = blockIdx.x * NWAVES + wave, NGW = G * NWAVES;
    unsigned char* ws = args.ws;
    bf16 *W1 = (bf16*)(ws + WS_W1), *WPB = (bf16*)(ws + WS_WPB), *WAB = (bf16*)(ws + WS_WAB), *WOUT = (bf16*)(ws + WS_WOUT), *WGU = (bf16*)(ws + WS_WGU), *WDN = (bf16*)(ws + WS_WDN);
    bf16 *HB = (bf16*)(ws + WS_H), *ZB = (bf16*)(ws + WS_Z), *QB = (bf16*)(ws + WS_Q), *KB = (bf16*)(ws + WS_K), *VB = (bf16*)(ws + WS_V);
    bf16 *PMB = (bf16*)(ws + WS_K), *OATT = (bf16*)(ws + WS_K + 16 * MiB), *GATED = (bf16*)(ws + WS_V), *MIXB = (bf16*)(ws + WS_H), *H2 = (bf16*)(ws + WS_V), *ACT = (bf16*)(ws + WS_Q), *FB = (bf16*)(ws + WS_H);
    bf16 *SGP = (bf16*)args.out, *SGA = SGP + (size_t)M * D;
    float* LSE = (float*)(ws + WS_LSE); const float* rope = (const float*)(ws + WS_ROPE);
    const int lo = args.ph_lo, hi = args.ph_hi;
    volatile LAS unsigned* MISC = (volatile LAS unsigned*)(lds + RING_BYTES + 320);
    unsigned* barw = (unsigned*)(ws + WS_CTL);
    if (tid < 32) MISC[tid] = 0u;
    if (lo == 0 && hi > 1 && blockIdx.x == 0) for (int i = tid; i < XCD_BAR_WORDS; i += NWAVES * 64) barw[i] = 0u;
    __syncthreads();
    XcdBarrier xbar; xbar.bar = barw; xbar.x = 0; xbar.st = MISC + 8;
#ifndef PH_MASK
#define PH_MASK 0x3ff
#endif
#define IN(k) (lo <= (k) && (k) < hi && ((PH_MASK >> (k)) & 1))
#define SEAM(k) do { if (IN(k) && IN((k) + 1)) { if ((k) == 0) { cg::this_grid().sync(); xbar = xcd_barrier_post(barw, MISC + 8); } else xcd_barrier(xbar); } } while (0)

#ifndef DUP_MASK
#define DUP_MASK 0
#endif
#define PHASE(k, ...) do { if (IN(k)) { for (int rep_ = 0; rep_ < (((DUP_MASK >> (k)) & 1) ? 2 : 1); ++rep_) { __VA_ARGS__ if (rep_ == 0 && ((DUP_MASK >> (k)) & 1)) cg::this_grid().sync(); } } } while (0)
    PHASE(0, p0_prologue(args, lds, wave, lane, gw, NGW); __syncthreads(););
    SEAM(0);
    PHASE(1,
        pg8::Gemm g{HB, W1, nullptr, nullptr, M, NIN, D}; pg8::StaticOrder S; S.init(M, NIN, G, (int)blockIdx.x);
        pg8::EpiProj E{ZB, QB, KB, VB, SGP, SGA, rope};
        pg8::gemm_phase<pg8::EpiProj, pg8::StaticOrder, true, true>(lds, g, S, E););
    SEAM(1);
    PHASE(2, attn_phase(lds, QB, KB, VB, LSE, wave, lane, gw, NGW); __syncthreads(););
    SEAM(2);
    PHASE(3, merge_pool_phase(QB, LSE, ZB, PMB, OATT, lane, gw, NGW););
    SEAM(3);
    PHASE(4,
        pg8::Gemm g{PMB, WPB, OATT, WAB, M, D, PW}; pg8::PairOrder S; S.S.init(M, D, G, (int)blockIdx.x);
        pg8::EpiGate E{SGP, SGA, GATED};
        pg8::gemm_phase<pg8::EpiGate, pg8::PairOrder, true, true>(lds, g, S, E););
    SEAM(4);
    PHASE(5,
        pg8::Gemm g{GATED, WOUT, nullptr, nullptr, M, D, D}; pg8::StaticOrder S; S.init(M, D, G, (int)blockIdx.x);
        pg8::EpiPlain E{MIXB, D};
        pg8::gemm_phase<pg8::EpiPlain, pg8::StaticOrder, true, true>(lds, g, S, E););
    SEAM(5);
    PHASE(6, rows_mid(args.in[0], MIXB, args.in[8], args.in[9], args.out, H2, lane, gw, NGW););
    SEAM(6);
    PHASE(7,
        pg8::Gemm g{H2, WGU, nullptr, nullptr, M, 2 * DFF, D}; pg8::StaticOrder S; S.init(M, 2 * DFF, G, (int)blockIdx.x);
        pg8::EpiSwiGLU E{ACT, DFF};
        pg8::gemm_phase<pg8::EpiSwiGLU, pg8::StaticOrder, true, true>(lds, g, S, E););
    SEAM(7);
    PHASE(8,
        pg8::Gemm g{ACT, WDN, nullptr, nullptr, M, D, DFF}; pg8::StaticOrder S; S.init(M, D, G, (int)blockIdx.x);
        pg8::EpiPlain E{FB, D};
        pg8::gemm_phase<pg8::EpiPlain, pg8::StaticOrder, true, true>(lds, g, S, E););
    SEAM(8);
    PHASE(9, rows_final(FB, args.in[13], args.out, lane, gw, NGW););
#undef PHASE
#undef IN
#undef SEAM
}

extern "C" void kernel_launch(void* const* d_in, const int* in_sizes, int n_in, void* d_out, int out_size, void* d_ws, size_t ws_size, hipStream_t stream) {
    static int grid = 0;
    if (grid == 0) {
        if (n_in != 14 || in_sizes[0] != M * D || out_size != M * D || ws_size < WS_END) { fprintf(stderr, "kernel_launch: unexpected shapes (n_in %d, in0 %d, out %d, ws %zu)\n", n_in, n_in > 0 ? in_sizes[0] : -1, out_size, ws_size); grid = -1; return; }
        int dev = 0, cus = 0, per_cu = 0;
        if (hipGetDevice(&dev) != hipSuccess || hipDeviceGetAttribute(&cus, hipDeviceAttributeMultiprocessorCount, dev) != hipSuccess) { grid = -1; return; }
        if (hipFuncSetAttribute((const void*)fwd_megakernel, hipFuncAttributeMaxDynamicSharedMemorySize, LDS_BYTES) != hipSuccess) { fprintf(stderr, "kernel_launch: hipFuncSetAttribute failed\n"); grid = -1; return; }
        if (hipOccupancyMaxActiveBlocksPerMultiprocessor(&per_cu, (const void*)fwd_megakernel, NWAVES * 64, LDS_BYTES) != hipSuccess || per_cu < 1) { fprintf(stderr, "kernel_launch: occupancy query says %d blocks per CU\n", per_cu); per_cu = 1; }
        (void)hipGetLastError();
        grid = cus * 1;
    }
    if (grid < 0) return;
    Args a{};
    for (int i = 0; i < 14; ++i) a.in[i] = (const float*)d_in[i];
    a.out = (float*)d_out; a.ws = (unsigned char*)d_ws;
#if MK_N_LAUNCHES == 1
    a.ph_lo = 0; a.ph_hi = NPH;
    void* kargs[] = {&a};
    hipError_t e = hipLaunchCooperativeKernel((const void*)fwd_megakernel, dim3(grid), dim3(NWAVES * 64), kargs, LDS_BYTES, stream);
    if (e != hipSuccess) fprintf(stderr, "kernel_launch: cooperative launch failed: %s (grid %d)\n", hipGetErrorString(e), grid);
#else
    for (int p = 0; p < NPH; ++p) { a.ph_lo = p; a.ph_hi = p + 1; hipLaunchKernelGGL(fwd_megakernel, dim3(grid), dim3(NWAVES * 64), LDS_BYTES, stream, a); }
#endif
}
```
